# Optimizing an MI355X kernel written in HIP

```python
import jax, jax.numpy as jnp
from jax import lax
import numpy as np

D_MODEL = 1024
BATCH = 4
SEQ = 4096
DEPTH = 2

HEAD_DIM = 64
N_HEADS = D_MODEL // HEAD_DIM
N_SB_HEADS = N_HEADS // 2
N_CA_HEADS = N_HEADS - N_SB_HEADS
D_SB = N_SB_HEADS * HEAD_DIM
D_CA = N_CA_HEADS * HEAD_DIM
D_IN = 3 * D_SB + 3 * D_CA
D_FF = 4 * D_MODEL
CHUNK = 64
LEFT_CHUNKS = 8
BAND = (LEFT_CHUNKS + 1) * CHUNK
REL_CLIP = 128
N_REL = 2 * REL_CLIP + 1
Q_BLOCK = 128
EPS = 1e-6
NEG_INF = -1e30

kernel_name = "hybrid_stickbreak_chunkrel_adaln_encoder"


def rmsnorm(x, g):
    xf = x.astype(jnp.float32)
    y = xf * lax.rsqrt(jnp.mean(xf * xf, axis=-1, keepdims=True) + EPS)
    return (y * g.astype(jnp.float32)).astype(x.dtype)


def stick_breaking_attention(q, k, v):
    B, S, H, d = q.shape
    scale = d ** -0.5
    outs = []
    for start in range(0, S, Q_BLOCK):
        end = start + Q_BLOCK
        qb = q[:, start:end]
        kb = k[:, :end]
        vb = v[:, :end]
        z = jnp.einsum('bqhd,bkhd->bhqk', qb, kb).astype(jnp.float32) * scale
        t_idx = start + jnp.arange(Q_BLOCK)[:, None]
        s_idx = jnp.arange(end)[None, :]
        strict = s_idx < t_idx
        log_beta = jax.nn.log_sigmoid(z)
        log_1m_beta = jnp.where(strict, jax.nn.log_sigmoid(-z), 0.0)
        suffix = lax.cumsum(log_1m_beta, axis=3, reverse=True) - log_1m_beta
        w = jnp.where(strict, jnp.exp(log_beta + suffix), 0.0)
        outs.append(jnp.einsum('bhqk,bkhd->bqhd', w.astype(v.dtype), vb))
    return jnp.concatenate(outs, axis=1)


def chunked_relpos_attention(q, k, v, rel_bias):
    B, S, H, d = q.shape
    nc = S // CHUNK
    pad = LEFT_CHUNKS * CHUNK
    kp = jnp.pad(k, ((0, 0), (pad, 0), (0, 0), (0, 0))).reshape(B, nc + LEFT_CHUNKS, CHUNK, H, d)
    vp = jnp.pad(v, ((0, 0), (pad, 0), (0, 0), (0, 0))).reshape(B, nc + LEFT_CHUNKS, CHUNK, H, d)
    k_band = jnp.concatenate([kp[:, i:i + nc] for i in range(LEFT_CHUNKS + 1)], axis=2)
    v_band = jnp.concatenate([vp[:, i:i + nc] for i in range(LEFT_CHUNKS + 1)], axis=2)
    qc = q.reshape(B, nc, CHUNK, H, d)
    s = jnp.einsum('bnqhd,bnkhd->bnhqk', qc, k_band).astype(jnp.float32) * (d ** -0.5)
    qi = jnp.arange(CHUNK)[:, None]
    kj = jnp.arange(BAND)[None, :]
    rel = qi + pad - kj
    rel_idx = jnp.clip(rel, -REL_CLIP, REL_CLIP) + REL_CLIP
    bias = rel_bias[:, rel_idx].astype(jnp.float32)
    s = s + bias[None, None]
    key_pos = jnp.arange(nc)[:, None] * CHUNK + kj - pad
    valid = key_pos >= 0
    s = jnp.where(valid[None, :, None, None, :], s, NEG_INF)
    p = jax.nn.softmax(s, axis=-1)
    out = jnp.einsum('bnhqk,bnkhd->bnqhd', p.astype(v.dtype), v_band)
    return out.reshape(B, S, H, d)


def setup_inputs(seed: int = 0) -> dict:
    key = jax.random.key(seed)
    ks = jax.random.split(key, 16)
    f32 = jnp.float32
    x = jax.random.normal(ks[0], (BATCH, SEQ, D_MODEL), f32)
    c = jax.random.normal(ks[1], (BATCH, D_MODEL), f32)
    g_norm1 = 1.0 + 0.01 * jax.random.normal(ks[2], (DEPTH, D_MODEL), f32)
    w_in = jax.random.normal(ks[3], (DEPTH, D_MODEL, D_IN), f32) * D_MODEL ** -0.5
    g_q = 1.0 + 0.01 * jax.random.normal(ks[4], (DEPTH, HEAD_DIM), f32)
    g_k = 1.0 + 0.01 * jax.random.normal(ks[5], (DEPTH, HEAD_DIM), f32)
    rel_bias = 0.1 * jax.random.normal(ks[6], (DEPTH, N_CA_HEADS, N_REL), f32)
    w_o = jax.random.normal(ks[7], (DEPTH, D_MODEL, D_MODEL), f32) * D_MODEL ** -0.5
    g_norm2 = 1.0 + 0.01 * jax.random.normal(ks[8], (DEPTH, D_MODEL), f32)
    w1 = jax.random.normal(ks[9], (DEPTH, D_MODEL, D_FF), f32) * D_MODEL ** -0.5
    w2 = jax.random.normal(ks[10], (DEPTH, D_FF, D_MODEL), f32) * D_FF ** -0.5
    w_ada = jax.random.normal(ks[11], (DEPTH, D_MODEL, 6 * D_MODEL), f32) * (0.5 * D_MODEL ** -0.5)
    b_ada = 0.01 * jax.random.normal(ks[12], (DEPTH, 6 * D_MODEL), f32)
    return {"x": x, "c": c, "g_norm1": g_norm1, "w_in": w_in, "g_q": g_q, "g_k": g_k,
            "rel_bias": rel_bias, "w_o": w_o, "g_norm2": g_norm2, "w1": w1, "w2": w2,
            "w_ada": w_ada, "b_ada": b_ada}


def reference(x, c, g_norm1, w_in, g_q, g_k, rel_bias, w_o, g_norm2, w1, w2, w_ada, b_ada):
    B, S, D = x.shape
    split_pts = [D_SB, 2 * D_SB, 3 * D_SB, 3 * D_SB + D_CA, 3 * D_SB + 2 * D_CA]
    c_act = jax.nn.silu(c)
    for l in range(DEPTH):
        mod = c_act @ w_ada[l] + b_ada[l]
        sh1, sc1, gt1, sh2, sc2, gt2 = [m[:, None, :] for m in jnp.split(mod, 6, axis=-1)]
        h = rmsnorm(x, g_norm1[l]) * (1.0 + sc1) + sh1
        proj = h @ w_in[l]
        q_sb, k_sb, v_sb, q_ca, k_ca, v_ca = jnp.split(proj, split_pts, axis=-1)
        hs = lambda t, n: t.reshape(B, S, n, HEAD_DIM)
        o_sb = stick_breaking_attention(hs(q_sb, N_SB_HEADS), hs(k_sb, N_SB_HEADS), hs(v_sb, N_SB_HEADS))
        q_ca = rmsnorm(hs(q_ca, N_CA_HEADS), g_q[l])
        k_ca = rmsnorm(hs(k_ca, N_CA_HEADS), g_k[l])
        o_ca = chunked_relpos_attention(q_ca, k_ca, hs(v_ca, N_CA_HEADS), rel_bias[l])
        mixed = jnp.concatenate([o_sb.reshape(B, S, D_SB), o_ca.reshape(B, S, D_CA)], axis=-1)
        x = x + gt1 * (mixed @ w_o[l])
        h = rmsnorm(x, g_norm2[l]) * (1.0 + sc2) + sh2
        x = x + gt2 * (jnp.square(jax.nn.relu(h @ w1[l])) @ w2[l])
    return x
```

```cpp
#include <hip/hip_runtime.h>
#include <hip/hip_cooperative_groups.h>
#include <cstdio>
#include <cstdint>
namespace cg = cooperative_groups;
namespace pg8 {
#define PG8_LAS __attribute__((address_space(3)))
typedef unsigned short bf16_t;
typedef short bf16x8 __attribute__((ext_vector_type(8)));
typedef float f32x4 __attribute__((ext_vector_type(4)));
typedef unsigned u32x4 __attribute__((ext_vector_type(4)));
constexpr int BM = 256, BK = 64, HALF = 128, HTB = HALF * BK * 2  , STAGE_BYTES = 8 * HTB, NXCD = 8, WGM = 8;

__host__ __device__ __forceinline__ int lds_byte(int r, int c) { const int st = (r >> 4) * 2 + (c >> 5), rr = r & 15, cc = c & 31, ob = rr * 64 + cc * 2; return st * 1024 + (ob ^ (((ob >> 9) & 1) << 5)); }
__host__ __device__ __forceinline__ void stage_rc(int b, int& R, int& C) { const int st = b / 1024, sb = b % 1024, swz = sb ^ (((sb >> 9) & 1) << 5); R = (st >> 1) * 16 + swz / 64; C = (st & 1) * 32 + (swz % 64) / 2; }
__host__ __device__ __forceinline__ int perm32(int rho) { const int n = rho >> 4, i = rho & 15; return 8 * (i >> 2) + 4 * n + (i & 3); }

struct Unit { int pm, pn; };
struct Gemm { const bf16_t* A; const bf16_t* Bt; int M, N, K; };

struct StaticOrder {
    int nM, nN, nwg, G, c;
    __host__ __device__ void init(int M, int N, int G_, int c_) { nM = M / BM; nN = N / BM; nwg = nM * nN; G = G_; c = c_; }
    __host__ __device__ bool next(int i, Unit& u) const {
        const long L = (long)i * G + c; if (L >= nwg) return false;
        int wgid = (int)L; { const int q = nwg / NXCD, r = nwg % NXCD, xcd = wgid % NXCD, off = wgid / NXCD; wgid = (xcd < r ? xcd * (q + 1) : r * (q + 1) + (xcd - r) * q) + off; }
        const int nig = WGM * nN, gid = wgid / nig, fm = gid * WGM, gsz = (nM - fm) < WGM ? (nM - fm) : WGM;
        u.pm = fm + ((wgid % nig) % gsz); u.pn = (wgid % nig) / gsz; return true;
    }
    __device__ __forceinline__ void a_ready(const Unit&) const {}
    __device__ __forceinline__ void done(const Unit&) const {}
};

__device__ __forceinline__ unsigned cvt_pk_bf16(float lo, float hi) { unsigned r; asm volatile("v_cvt_pk_bf16_f32 %0, %1, %2" : "=v"(r) : "v"(lo), "v"(hi)); return r; }
typedef float f32x2 __attribute__((ext_vector_type(2)));
typedef unsigned u32x4 __attribute__((ext_vector_type(4)));
template <int ACT> struct EpiBf16 {
    static constexpr bool PERM = true, AFTER_DRAIN = false;
    bf16_t* O; int ldc;
    __device__ __forceinline__ void operator()(const f32x4 (&acc)[2][2][4][2], const Unit& u, int wr, int wc, int fr, int fq) const {
        const int row0 = u.pm * BM + wr * 64 + fr; const int col0 = u.pn * BM + wc * 32 + 8 * fq;
#pragma unroll
        for (int ai = 0; ai < 2; ++ai)
#pragma unroll
            for (int m = 0; m < 4; ++m) { bf16_t* rowp = O + (size_t)(row0 + ai * HALF + m * 16) * ldc + col0;
#pragma unroll
                for (int bj = 0; bj < 2; ++bj) { f32x4 v0 = acc[ai][bj][m][0], v1 = acc[ai][bj][m][1];
                    if (ACT == 2) {
#pragma unroll
                        for (int e = 0; e < 4; ++e) { const float a = fmaxf(v0[e], 0.f), b = fmaxf(v1[e], 0.f); v0[e] = a * a; v1[e] = b * b; } }
                    u32x4 w; w.x = cvt_pk_bf16(v0[0], v0[1]); w.y = cvt_pk_bf16(v0[2], v0[3]); w.z = cvt_pk_bf16(v1[0], v1[1]); w.w = cvt_pk_bf16(v1[2], v1[3]);
                    *(u32x4*)(rowp + bj * HALF) = w; } }
    }
};
struct EpiResGate {
    static constexpr bool PERM = false, AFTER_DRAIN = false;
    const float* base; float* out; const float* gate; int ldc, gate_ld, rows_per_batch;
    __device__ __forceinline__ void operator()(const f32x4 (&acc)[2][2][4][2], const Unit& u, int wr, int wc, int fr, int fq) const {
        const int col0 = u.pn * BM + wc * 32 + 4 * fq; const int b = (u.pm * BM) / rows_per_batch;
        f32x4 gv[2][2];
#pragma unroll
        for (int bj = 0; bj < 2; ++bj)
#pragma unroll
            for (int n = 0; n < 2; ++n) gv[bj][n] = *(const f32x4*)(gate + (size_t)b * gate_ld + col0 + bj * HALF + n * 16);
#pragma unroll
        for (int ai = 0; ai < 2; ++ai)
#pragma unroll
            for (int m = 0; m < 4; ++m) { const size_t off = (size_t)(u.pm * BM + ai * HALF + wr * 64 + m * 16 + fr) * ldc + col0;
#pragma unroll
                for (int bj = 0; bj < 2; ++bj)
#pragma unroll
                    for (int n = 0; n < 2; ++n) { const f32x4 bs = *(const f32x4*)(base + off + bj * HALF + n * 16);
                        *(f32x4*)(out + off + bj * HALF + n * 16) = bs + gv[bj][n] * acc[ai][bj][m][n]; } }
    }
};
template <class Epi, class Sched, bool ALIGN_EPI = false, bool SP2 = false>
__device__ __forceinline__ void gemm_phase(PG8_LAS unsigned char* lds, const Gemm g, const Sched& S, const Epi& E) {
    int tid0_ = threadIdx.x; asm volatile("" : "+v"(tid0_));
    const int tid = tid0_, wid = __builtin_amdgcn_readfirstlane(tid >> 6), lane = tid & 63, wr = wid >> 2, wc = wid & 3, fr = lane & 15, fq = lane >> 4;
    const int K = g.K, nt = K / BK;
    unsigned voffA[2], voffB[2];
#pragma unroll
    for (int i = 0; i < 2; ++i) { int R, C; stage_rc(tid * 16 + i * 8192, R, C); const int Rb = Epi::PERM ? ((R & ~31) + perm32(R & 31)) : R;
        voffA[i] = (unsigned)(R * K + C) * 2u; voffB[i] = (unsigned)(Rb * K + C) * 2u; }
    const size_t kstep = (size_t)(BK * 2);
    const size_t hstep = (size_t)HALF * K * 2;
    const size_t tstep = 2 * hstep;
    const unsigned ldsw = (unsigned)wid * 1024u;
    const int aoff = lds_byte(wr * 64 + fr, fq * 8), boff = lds_byte(wc * 32 + fr, fq * 8);
#define PG8_SA(b, h) (((b) * 2 + (h)) * HTB)
#define PG8_SB(b, h) ((4 + (b) * 2 + (h)) * HTB)
#define PG8_STAGE(bufoff, gbase, voff) do { _Pragma("unroll") for (int _i = 0; _i < 2; ++_i) \
        __builtin_amdgcn_global_load_lds((const unsigned*)((const char*)(gbase) + (voff)[_i]), (PG8_LAS unsigned*)(lds + (bufoff) + ldsw + _i * 8192), 16, 0, 0); } while (0)
#define PG8_LDA(dst, b, h) do { _Pragma("unroll") for (int m = 0; m < 4; ++m) _Pragma("unroll") for (int k = 0; k < 2; ++k) dst[m][k] = *(const PG8_LAS bf16x8*)(lds + PG8_SA(b, h) + aoff + m * 2048 + k * 1024); } while (0)
#define PG8_LDB(dst, b, h) do { _Pragma("unroll") for (int n = 0; n < 2; ++n) _Pragma("unroll") for (int k = 0; k < 2; ++k) dst[n][k] = *(const PG8_LAS bf16x8*)(lds + PG8_SB(b, h) + boff + n * 2048 + k * 1024); } while (0)
#define PG8_MMA(ai, bj, At, Bt) do { __builtin_amdgcn_s_setprio(1); _Pragma("unroll") for (int m = 0; m < 4; ++m) _Pragma("unroll") for (int n = 0; n < 2; ++n) _Pragma("unroll") for (int k = 0; k < 2; ++k) \
        acc[ai][bj][m][n] = __builtin_amdgcn_mfma_f32_16x16x32_bf16(Bt[n][k], At[m][k], acc[ai][bj][m][n], 0, 0, 0); __builtin_amdgcn_s_setprio(0); } while (0)
#define PG8_WAIT_V(n) asm volatile("s_waitcnt vmcnt(" #n ")" ::: "memory")
#define PG8_WAIT_L(n) asm volatile("s_waitcnt lgkmcnt(" #n ")" ::: "memory")
#define PG8_BAR __builtin_amdgcn_s_barrier()
#define PG8_SCHED __builtin_amdgcn_sched_barrier(0)
    Unit cur, nxt; int ui = 0;
    if (!S.next(0, cur)) return;
    f32x4 acc[2][2][4][2];
#pragma unroll
    for (int a = 0; a < 2; ++a)
#pragma unroll
        for (int b = 0; b < 2; ++b)
#pragma unroll
            for (int m = 0; m < 4; ++m)
#pragma unroll
                for (int n = 0; n < 2; ++n) acc[a][b][m][n] = (f32x4){0.f, 0.f, 0.f, 0.f};
    bf16x8 At[4][2], B0[2][2], B1[2][2];
    const char* cA = (const char*)g.A + (size_t)cur.pm * tstep; const char* cB = (const char*)g.Bt + (size_t)cur.pn * tstep;
    S.a_ready(cur);
    if constexpr (SP2) {
        PG8_STAGE(PG8_SB(0, 0), cB, voffB); PG8_STAGE(PG8_SB(0, 1), cB + hstep, voffB); PG8_STAGE(PG8_SA(0, 0), cA, voffA); PG8_STAGE(PG8_SA(0, 1), cA + hstep, voffA);
        if (wr == 1) PG8_BAR;
        PG8_WAIT_V(2); PG8_BAR;
        PG8_STAGE(PG8_SB(1, 0), cB + kstep, voffB); PG8_STAGE(PG8_SA(1, 0), cA + kstep, voffA); PG8_STAGE(PG8_SB(1, 1), cB + hstep + kstep, voffB);
        PG8_WAIT_V(6); PG8_BAR;
    } else {
        PG8_STAGE(PG8_SB(0, 0), cB, voffB); PG8_STAGE(PG8_SA(0, 0), cA, voffA); PG8_STAGE(PG8_SB(0, 1), cB + hstep, voffB); PG8_STAGE(PG8_SA(0, 1), cA + hstep, voffA);
        if (wr == 1) PG8_BAR;
        PG8_WAIT_V(4); PG8_BAR;
        PG8_STAGE(PG8_SB(1, 0), cB + kstep, voffB); PG8_STAGE(PG8_SA(1, 0), cA + kstep, voffA); PG8_STAGE(PG8_SB(1, 1), cB + hstep + kstep, voffB);
        PG8_WAIT_V(6); PG8_BAR;
    }
    for (;;) {
        const bool has_next = S.next(ui + 1, nxt);
        const char* nA = has_next ? (const char*)g.A + (size_t)nxt.pm * tstep : cA; const char* nB = has_next ? (const char*)g.Bt + (size_t)nxt.pn * tstep : cB;
        for (int t = 0; t < nt; t += 2) {
            const bool last = (t == nt - 2);
            const char* a1 = cA + (size_t)(t + 1) * kstep;
            const char* a2 = last ? nA : cA + (size_t)(t + 2) * kstep; const char* b2 = last ? nB : cB + (size_t)(t + 2) * kstep;
            const char* a3 = a2 + kstep; const char* b3 = b2 + kstep;
            if (last && has_next) S.a_ready(nxt);
            if constexpr (SP2) {
            PG8_LDB(B0, 0, 0); PG8_LDB(B1, 0, 1); PG8_SCHED; PG8_LDA(At, 0, 0); PG8_STAGE(PG8_SA(1, 1), a1 + hstep, voffA);
            PG8_WAIT_V(8); PG8_WAIT_L(0); PG8_BAR; PG8_MMA(0, 0, At, B0); PG8_MMA(0, 1, At, B1); PG8_BAR; PG8_SCHED;
            PG8_LDA(At, 0, 1); PG8_STAGE(PG8_SB(0, 0), b2, voffB); PG8_STAGE(PG8_SB(0, 1), b2 + hstep, voffB); PG8_STAGE(PG8_SA(0, 0), a2, voffA);
            PG8_WAIT_V(8); PG8_WAIT_L(0); PG8_BAR; PG8_MMA(1, 0, At, B0); PG8_MMA(1, 1, At, B1); PG8_BAR; PG8_SCHED;
            PG8_LDB(B0, 1, 0); PG8_LDB(B1, 1, 1); PG8_SCHED; PG8_LDA(At, 1, 0); PG8_STAGE(PG8_SA(0, 1), a2 + hstep, voffA);
            PG8_WAIT_V(8); PG8_WAIT_L(0); PG8_BAR; PG8_MMA(0, 0, At, B0); PG8_MMA(0, 1, At, B1); PG8_BAR; PG8_SCHED;
            PG8_LDA(At, 1, 1); PG8_STAGE(PG8_SB(1, 0), b3, voffB); PG8_STAGE(PG8_SB(1, 1), b3 + hstep, voffB); PG8_STAGE(PG8_SA(1, 0), a3, voffA);
            PG8_WAIT_V(8); PG8_WAIT_L(0); PG8_BAR; PG8_MMA(1, 0, At, B0); PG8_MMA(1, 1, At, B1); PG8_BAR; PG8_SCHED;
            } else {
            PG8_LDB(B0, 0, 0); PG8_SCHED; PG8_LDA(At, 0, 0); PG8_STAGE(PG8_SA(1, 1), a1 + hstep, voffA);
            PG8_WAIT_L(8); PG8_BAR; PG8_WAIT_L(0); PG8_MMA(0, 0, At, B0); PG8_BAR; PG8_SCHED;
            PG8_LDB(B1, 0, 1); PG8_STAGE(PG8_SB(0, 0), b2, voffB);
            PG8_BAR; PG8_WAIT_L(0); PG8_MMA(0, 1, At, B1); PG8_BAR;
            PG8_LDA(At, 0, 1); PG8_STAGE(PG8_SA(0, 0), a2, voffA);
            PG8_BAR; PG8_WAIT_L(0); PG8_MMA(1, 0, At, B0); PG8_BAR; PG8_SCHED;
            PG8_STAGE(PG8_SB(0, 1), b2 + hstep, voffB);
            PG8_WAIT_V(6); PG8_BAR; PG8_MMA(1, 1, At, B1); PG8_BAR;
            PG8_LDB(B0, 1, 0); PG8_SCHED; PG8_LDA(At, 1, 0); PG8_STAGE(PG8_SA(0, 1), a2 + hstep, voffA);
            PG8_WAIT_L(8); PG8_BAR; PG8_WAIT_L(0); PG8_MMA(0, 0, At, B0); PG8_BAR; PG8_SCHED;
            PG8_LDB(B1, 1, 1); PG8_STAGE(PG8_SB(1, 0), b3, voffB);
            PG8_BAR; PG8_WAIT_L(0); PG8_MMA(0, 1, At, B1); PG8_BAR;
            PG8_LDA(At, 1, 1); PG8_STAGE(PG8_SA(1, 0), a3, voffA);
            PG8_BAR; PG8_WAIT_L(0); PG8_MMA(1, 0, At, B0); PG8_BAR; PG8_SCHED;
            PG8_STAGE(PG8_SB(1, 1), b3 + hstep, voffB);
            PG8_WAIT_V(6); PG8_BAR; PG8_MMA(1, 1, At, B1); PG8_BAR;
            }
        }
        if constexpr (ALIGN_EPI) { if (wr == 0) PG8_BAR; }
        if constexpr (!Epi::AFTER_DRAIN) { E(acc, cur, wr, wc, fr, fq); S.done(cur); }
        if (!has_next) break;
#pragma unroll
        for (int a = 0; a < 2; ++a)
#pragma unroll
            for (int b = 0; b < 2; ++b)
#pragma unroll
                for (int m = 0; m < 4; ++m)
#pragma unroll
                    for (int n = 0; n < 2; ++n) acc[a][b][m][n] = (f32x4){0.f, 0.f, 0.f, 0.f};
        cur = nxt; cA = nA; cB = nB; ++ui;
        if constexpr (ALIGN_EPI) { if (wr == 1) PG8_BAR; }
    }
    PG8_WAIT_V(0);
    if constexpr (!ALIGN_EPI) { if (wr == 0) PG8_BAR; }
    PG8_BAR;
    if constexpr (Epi::AFTER_DRAIN) { E.fused(acc, cur, wr, wc, fr, fq, lds, wid, lane); S.done(cur); }
#undef PG8_SA
#undef PG8_SB
#undef PG8_STAGE
#undef PG8_LDA
#undef PG8_LDB
#undef PG8_MMA
#undef PG8_WAIT_V
#undef PG8_WAIT_L
#undef PG8_BAR
#undef PG8_SCHED
}
}
namespace att {
#define ATT_LAS __attribute__((address_space(3)))
typedef unsigned short bf16_t;
typedef short bf16x8 __attribute__((ext_vector_type(8)));
typedef _Float16 f16x8 __attribute__((ext_vector_type(8)));
typedef float f32x16 __attribute__((ext_vector_type(16)));
typedef float f32x4 __attribute__((ext_vector_type(4)));
typedef unsigned u32x4 __attribute__((ext_vector_type(4)));
typedef unsigned u32x2 __attribute__((ext_vector_type(2)));
typedef short v4i16_t __attribute__((ext_vector_type(4)));
constexpr int PP = 3072, SEQ = 4096, DM = 1024;
constexpr float LOG2E = 1.4426950408889634f, QS = 0.125f * 1.4426950408889634f, EPS = 1e-6f;
constexpr int WAVE_LDS = 8192;
__device__ __forceinline__ int crow(int r, int hi) { return (r & 3) + 8 * (r >> 2) + 4 * hi; }
typedef float f32x2_t __attribute__((ext_vector_type(2))); typedef __bf16 bf16x2_t __attribute__((ext_vector_type(2)));
__device__ __forceinline__ unsigned cvtpk(float lo, float hi) { f32x2_t v = {lo, hi}; bf16x2_t b = __builtin_convertvector(v, bf16x2_t); return __builtin_bit_cast(unsigned, b); }
__device__ __forceinline__ float bf2f(short s) { return __uint_as_float(((unsigned)(unsigned short)s) << 16); }
__device__ __forceinline__ float half_add(float v) { auto rr = __builtin_amdgcn_permlane32_swap(__float_as_uint(v), __float_as_uint(v), false, false); return __uint_as_float(rr[0]) + __uint_as_float(rr[1]); }
__device__ __forceinline__ float half_max(float v) { auto rr = __builtin_amdgcn_permlane32_swap(__float_as_uint(v), __float_as_uint(v), false, false); return fmaxf(__uint_as_float(rr[0]), __uint_as_float(rr[1])); }
__device__ __forceinline__ v4i16_t vtr(ATT_LAS const char* p) { return __builtin_amdgcn_ds_read_tr16_b64_v4i16((ATT_LAS v4i16_t*)p); }
#define ATT_FENCE() asm volatile("" ::: "memory")
#define ATT_LWAIT() asm volatile("s_waitcnt lgkmcnt(0)" ::: "memory")

__device__ __forceinline__ void pv_tile(f32x16& o0, f32x16& o1, ATT_LAS const char* wl, int lane, const bf16x8 (&pf)[2]) {
    const int hi = lane >> 5;
    ATT_LAS const char* vb = wl + (4 * hi + ((lane & 15) >> 2)) * 64 + ((lane >> 4) & 1) * 32 + (lane & 3) * 8;
#pragma unroll
    for (int db = 0; db < 2; ++db)
#pragma unroll
        for (int sl = 0; sl < 2; ++sl) {
            const v4i16_t lo = vtr(vb + (db * 2 + sl) * 1024), hh = vtr(vb + (db * 2 + sl) * 1024 + 512);
            const bf16x8 vf = (bf16x8){lo[0], lo[1], lo[2], lo[3], hh[0], hh[1], hh[2], hh[3]};
            if (db == 0) o0 = __builtin_amdgcn_mfma_f32_32x32x16_bf16(vf, pf[sl], o0, 0, 0, 0);
            else         o1 = __builtin_amdgcn_mfma_f32_32x32x16_bf16(vf, pf[sl], o1, 0, 0, 0);
        }
}
__device__ __forceinline__ void store_ot(bf16_t* Op, const f32x16& o0, const f32x16& o1, float sc) {
#pragma unroll
    for (int g = 0; g < 4; ++g) {
        u32x2 a, b; a.x = cvtpk(o0[4 * g] * sc, o0[4 * g + 1] * sc); a.y = cvtpk(o0[4 * g + 2] * sc, o0[4 * g + 3] * sc);
        b.x = cvtpk(o1[4 * g] * sc, o1[4 * g + 1] * sc); b.y = cvtpk(o1[4 * g + 2] * sc, o1[4 * g + 3] * sc);
        *(u32x2*)(Op + 8 * g) = a; *(u32x2*)(Op + 32 + 8 * g) = b;
    }
}

__device__ __forceinline__ void sb_unit(const bf16_t* proj, bf16_t* mix, int b, int h, int qb, ATT_LAS char* wl, int lane) {
    const int r32 = lane & 31, hi = lane >> 5, t0 = qb * 32;
    const size_t rowbase = (size_t)b * SEQ;
    const bf16_t* Qp = proj + (rowbase + t0 + r32) * PP + h * 64 + hi * 8;
    const bf16_t* Kp = proj + rowbase * PP + 512 + h * 64 + hi * 8;
    const bf16_t* Vp = proj + rowbase * PP + 1024 + h * 64 + 8 * (lane & 3);
    bf16x8 qr[4];
#pragma unroll
    for (int d0 = 0; d0 < 4; ++d0) qr[d0] = *(const bf16x8*)(Qp + d0 * 16);
    f16x8 uf[2];
#pragma unroll
    for (int sl = 0; sl < 2; ++sl)
#pragma unroll
        for (int j = 0; j < 8; ++j) uf[sl][j] = ((16 * sl + 8 * (j >> 2) + 4 * hi + (j & 3)) > r32) ? (_Float16)1.0f : (_Float16)0.0f;
    f32x16 o0 = {}, o1 = {}; float R = 0.f;
    for (int kt = qb; kt >= 0; --kt) {
        const int k0 = kt * 32;
        bf16x8 kf[4]; u32x4 vv[4];
#pragma unroll
        for (int d0 = 0; d0 < 4; ++d0) kf[d0] = *(const bf16x8*)(Kp + (size_t)(k0 + r32) * PP + d0 * 16);
#pragma unroll
        for (int i = 0; i < 4; ++i) vv[i] = *(const u32x4*)(Vp + (size_t)(k0 + 16 * (i & 1) + (lane >> 2)) * PP + 32 * (i >> 1));
        f32x16 p = {};
#pragma unroll
        for (int d0 = 0; d0 < 4; ++d0) p = __builtin_amdgcn_mfma_f32_32x32x16_bf16(kf[d0], qr[d0], p, 0, 0, 0);
        ATT_FENCE();
#pragma unroll
        for (int i = 0; i < 4; ++i) *(ATT_LAS u32x4*)(wl + i * 1024 + lane * 16) = vv[i];
        const bool diag = (kt == qb);
        f32x16 lb; f16x8 lf[2];
#pragma unroll
        for (int r = 0; r < 16; ++r) {
            const float z = p[r] * QS, e = __builtin_amdgcn_exp2f(-fabsf(z)), lg = __builtin_amdgcn_logf(1.0f + e);
            const float lbv = fminf(z, 0.f) - lg; float l1 = lbv - z;
            if (diag && !(crow(r, hi) < r32)) l1 = 0.f;
            lb[r] = lbv; lf[r >> 3][r & 7] = (_Float16)l1;
        }
        f32x16 suf = {};
        suf = __builtin_amdgcn_mfma_f32_32x32x16_f16(uf[0], lf[0], suf, 0, 0, 0);
        suf = __builtin_amdgcn_mfma_f32_32x32x16_f16(uf[1], lf[1], suf, 0, 0, 0);
        const float tl = suf[0] + (float)lf[0][0];
        const float tot = __shfl(tl, r32);
        bf16x8 pf[2];
#pragma unroll
        for (int sl = 0; sl < 2; ++sl) {
            float w[8];
#pragma unroll
            for (int j = 0; j < 8; ++j) { const int r = 8 * sl + j; float wv = __builtin_amdgcn_exp2f(lb[r] + suf[r] + R); if (diag && !(crow(r, hi) < r32)) wv = 0.f; w[j] = wv; }
            u32x4 t; t.x = cvtpk(w[0], w[1]); t.y = cvtpk(w[2], w[3]); t.z = cvtpk(w[4], w[5]); t.w = cvtpk(w[6], w[7]);
            pf[sl] = __builtin_bit_cast(bf16x8, t);
        }
        R += tot;
        ATT_LWAIT();
        pv_tile(o0, o1, wl, lane, pf);
        ATT_FENCE();
        if (__all(R < -160.0f)) break;
    }
    store_ot(mix + (rowbase + t0 + r32) * DM + h * 64 + 4 * hi, o0, o1, 1.0f);
}

__device__ __forceinline__ void ca_unit(const bf16_t* proj, bf16_t* mix, const float* gq, const float* gk, const float* relb, int b, int h, int qb, ATT_LAS char* wl, int lane) {
    const int r32 = lane & 31, hi = lane >> 5, t0 = qb * 32, n = t0 >> 6, qi = (t0 & 63) + r32;
    const size_t rowbase = (size_t)b * SEQ;
    const bf16_t* Qp = proj + (rowbase + t0 + r32) * PP + 1536 + h * 64 + hi * 8;
    const bf16_t* Kp = proj + rowbase * PP + 2048 + h * 64 + hi * 8;
    const bf16_t* Vp = proj + rowbase * PP + 2560 + h * 64 + 8 * (lane & 3);
    ATT_LAS float* rks = (ATT_LAS float*)(wl + 4096);
    ATT_LAS float* bt = (ATT_LAS float*)(wl + 4352);
    for (int i = lane; i < 257; i += 64) bt[i] = relb[h * 257 + i] * LOG2E;
    bf16x8 qr[4];
    {
        bf16x8 qraw[4]; float ss = 0.f;
#pragma unroll
        for (int d0 = 0; d0 < 4; ++d0) { qraw[d0] = *(const bf16x8*)(Qp + d0 * 16);
#pragma unroll
            for (int j = 0; j < 8; ++j) { const float f = bf2f(qraw[d0][j]); ss += f * f; } }
        ss = half_add(ss);
        const float rinv = __builtin_amdgcn_rsqf(ss * (1.0f / 64.0f) + EPS) * QS;
#pragma unroll
        for (int d0 = 0; d0 < 4; ++d0) { float f[8];
#pragma unroll
            for (int j = 0; j < 8; ++j) { const int d = 16 * d0 + 8 * hi + j; f[j] = bf2f(qraw[d0][j]) * rinv * gq[d] * gk[d]; }
            u32x4 t; t.x = cvtpk(f[0], f[1]); t.y = cvtpk(f[2], f[3]); t.z = cvtpk(f[4], f[5]); t.w = cvtpk(f[6], f[7]);
            qr[d0] = __builtin_bit_cast(bf16x8, t); }
    }
    ATT_LWAIT();
    const float bconst = bt[256];
    f32x16 o0 = {}, o1 = {}; float mref = 0.f, l = 0.f;
    const int band0 = (n - 8) * 64;
    const int kstart = band0 < 0 ? 0 : band0;
    const int ntiles = (n * 64 + 64 - kstart) >> 5;
    for (int it = 0; it < ntiles; ++it) {
        const int k0 = kstart + 32 * it;
        bf16x8 kf[4]; u32x4 vv[4];
#pragma unroll
        for (int d0 = 0; d0 < 4; ++d0) kf[d0] = *(const bf16x8*)(Kp + (size_t)(k0 + r32) * PP + d0 * 16);
#pragma unroll
        for (int i = 0; i < 4; ++i) vv[i] = *(const u32x4*)(Vp + (size_t)(k0 + 16 * (i & 1) + (lane >> 2)) * PP + 32 * (i >> 1));
        f32x16 p = {};
#pragma unroll
        for (int d0 = 0; d0 < 4; ++d0) p = __builtin_amdgcn_mfma_f32_32x32x16_bf16(kf[d0], qr[d0], p, 0, 0, 0);
        float ks = 0.f;
#pragma unroll
        for (int d0 = 0; d0 < 4; ++d0)
#pragma unroll
            for (int j = 0; j < 8; ++j) { const float f = bf2f(kf[d0][j]); ks += f * f; }
        ks = half_add(ks);
        const float rk = __builtin_amdgcn_rsqf(ks * (1.0f / 64.0f) + EPS);
        ATT_FENCE();
        rks[r32] = rk;
#pragma unroll
        for (int i = 0; i < 4; ++i) *(ATT_LAS u32x4*)(wl + i * 1024 + lane * 16) = vv[i];
        ATT_LWAIT();
        float s[16];
#pragma unroll
        for (int g = 0; g < 4; ++g) { const f32x4 rv = *(ATT_LAS const f32x4*)(rks + 8 * g + 4 * hi);
#pragma unroll
            for (int e = 0; e < 4; ++e) s[4 * g + e] = p[4 * g + e] * rv[e]; }
        const int kj0 = k0 - band0;
        if (kj0 >= 384) {
#pragma unroll
            for (int r = 0; r < 16; ++r) { int rel = qi + 512 - (kj0 + crow(r, hi)); rel = rel < -128 ? -128 : (rel > 128 ? 128 : rel); s[r] += bt[rel + 128]; }
        } else {
#pragma unroll
            for (int r = 0; r < 16; ++r) s[r] += bconst;
        }
        float rm = s[0];
#pragma unroll
        for (int r = 1; r < 16; ++r) rm = fmaxf(rm, s[r]);
        rm = half_max(rm);
        if (it == 0) mref = rm;
        else if (__any(rm - mref > 14.0f)) {
            const float dl = fmaxf(rm - mref, 0.f), al = __builtin_amdgcn_exp2f(-dl);
#pragma unroll
            for (int r = 0; r < 16; ++r) { o0[r] *= al; o1[r] *= al; }
            l *= al; mref += dl;
        }
        float ls = 0.f; bf16x8 pf[2];
#pragma unroll
        for (int sl = 0; sl < 2; ++sl) {
            float w[8];
#pragma unroll
            for (int j = 0; j < 8; ++j) { w[j] = __builtin_amdgcn_exp2f(s[8 * sl + j] - mref); ls += w[j]; }
            u32x4 t; t.x = cvtpk(w[0], w[1]); t.y = cvtpk(w[2], w[3]); t.z = cvtpk(w[4], w[5]); t.w = cvtpk(w[6], w[7]);
            pf[sl] = __builtin_bit_cast(bf16x8, t);
        }
        l += ls;
        pv_tile(o0, o1, wl, lane, pf);
        ATT_FENCE();
    }
    l = half_add(l);
    store_ot(mix + (rowbase + t0 + r32) * DM + 512 + h * 64 + 4 * hi, o0, o1, 1.0f / l);
}
}
#ifndef MK_MULTI
#define MK_MULTI 0
#endif
constexpr int NWAVES = 8;
constexpr int BATCH = 4, SEQ = 4096, D = 1024, M = BATCH * SEQ, DIN = 3072, FF = 4096, DEPTH = 2, NREL = 257, MODW = 6 * D;
constexpr float RMS_EPS = 1e-6f;
constexpr size_t MiB = 1u << 20;
constexpr size_t WS_CTL = 0, CTL_ZERO_BYTES = 1 * MiB, WS_MOD = 65536;
constexpr size_t WS_W = 2 * MiB, W_LAYER = 24 * MiB, W_IN = 0, W_O = 6 * MiB, W_1 = 8 * MiB, W_2 = 16 * MiB;
constexpr size_t WS_XN = 64 * MiB, WS_PROJ = 96 * MiB, WS_MIX = 192 * MiB, WS_H = 96 * MiB, WS_END = 224 * MiB;
static_assert(WS_MOD + (size_t)DEPTH * BATCH * MODW * 4 <= CTL_ZERO_BYTES && WS_W + DEPTH * W_LAYER <= WS_XN && WS_H + (size_t)M * FF * 2 <= WS_END, "ws map");
constexpr int RING_BYTES = 131072, LDS_BYTES = 147456;
constexpr int NPHASE = 1 + 7 * DEPTH;

#define GAS __attribute__((address_space(1)))
#define LAS __attribute__((address_space(3)))
typedef unsigned short bf16;
typedef unsigned v4u __attribute__((ext_vector_type(4)));
typedef float f32x4 __attribute__((ext_vector_type(4)));
#define LDS_WAIT() asm volatile("s_waitcnt lgkmcnt(0)" ::: "memory")
__device__ __forceinline__ unsigned f2bf(float f) { unsigned u = __builtin_bit_cast(unsigned, f); return (u + 0x7fffu + ((u >> 16) & 1u)) >> 16; }
__device__ __forceinline__ unsigned pk2(float lo, float hi) { return f2bf(lo) | (f2bf(hi) << 16); }
__device__ __forceinline__ float wave_sum(float v) {
#pragma unroll
    for (int o = 1; o < 64; o <<= 1) v += __shfl_xor(v, o);
    return v;
}
__device__ __forceinline__ void transpose_item(const float* W, int K, int N, bf16* WT, LAS float* scr, int item, int lane) {
    const int nblk = N / 32, kb = item / nblk, nb = item % nblk, k0 = 64 * kb, n0 = 32 * nb;
#pragma unroll 8
    for (int i = 0; i < 32; ++i) { const int kk = 2 * i + (lane >> 5); scr[kk * 33 + (lane & 31)] = W[(size_t)(k0 + kk) * N + n0 + (lane & 31)]; }
    LDS_WAIT(); asm volatile("" ::: "memory");
    const int c = lane & 7;
#pragma unroll
    for (int j = 0; j < 4; ++j) { const int n = (lane >> 3) + 8 * j; const LAS float* s = scr + (8 * c) * 33 + n;
        v4u o; o.x = pk2(s[0 * 33], s[1 * 33]); o.y = pk2(s[2 * 33], s[3 * 33]); o.z = pk2(s[4 * 33], s[5 * 33]); o.w = pk2(s[6 * 33], s[7 * 33]);
        *(v4u*)(WT + (size_t)(n0 + n) * K + k0 + 8 * c) = o; }
    LDS_WAIT(); asm volatile("" ::: "memory");
}
__device__ __forceinline__ void mod_item(const float* cvec, const float* w_ada, const float* b_ada, float* mod, int item, int lane) {
    const int kc = item & 15, jb = (item >> 4) % (MODW / 64), l = (item >> 4) / (MODW / 64), j = jb * 64 + lane;
    float sv[BATCH];
#pragma unroll
    for (int b = 0; b < BATCH; ++b) { const float cv = cvec[b * D + kc * 64 + lane]; sv[b] = cv / (1.0f + __expf(-cv)); }
    float acc[BATCH] = {0.f, 0.f, 0.f, 0.f};
    const float* wp = w_ada + ((size_t)l * D + kc * 64) * MODW + j;
#pragma unroll 16
    for (int k = 0; k < 64; ++k) { const float w = wp[(size_t)k * MODW];
#pragma unroll
        for (int b = 0; b < BATCH; ++b) acc[b] += __uint_as_float(__builtin_amdgcn_readlane(__float_as_uint(sv[b]), k)) * w; }
    if (kc == 0) { const float bb = b_ada[l * MODW + j];
#pragma unroll
        for (int b = 0; b < BATCH; ++b) acc[b] += bb; }
#pragma unroll
    for (int b = 0; b < BATCH; ++b) atomicAdd(mod + ((size_t)l * BATCH + b) * MODW + j, acc[b]);
}
__device__ __forceinline__ void norm_phase(const float* X, bf16* XN, const float* g, const float* modl  , int sh_off, int sc_off, int gw, int NGW, int lane) {
    for (int m0 = gw * 8; m0 < M; m0 += NGW * 8) {
        const int b = m0 / SEQ; const float* mb = modl + (size_t)b * MODW;
        f32x4 A[4], Bv[4];
#pragma unroll
        for (int j = 0; j < 4; ++j) { const int c = 4 * lane + 256 * j; const f32x4 gv = *(const f32x4*)(g + c), sc = *(const f32x4*)(mb + sc_off + c); A[j] = gv * (sc + 1.0f); Bv[j] = *(const f32x4*)(mb + sh_off + c); }
        for (int i = 0; i < 8; ++i) {
            const f32x4* xr = (const f32x4*)(X + (size_t)(m0 + i) * D) + lane;
            f32x4 v[4]; float s = 0.f;
#pragma unroll
            for (int j = 0; j < 4; ++j) { v[j] = xr[64 * j]; s += (v[j].x * v[j].x + v[j].y * v[j].y) + (v[j].z * v[j].z + v[j].w * v[j].w); }
            const float rinv = 1.0f / sqrtf(wave_sum(s) * (1.0f / D) + RMS_EPS);
            unsigned long long* o8 = (unsigned long long*)(XN + (size_t)(m0 + i) * D) + lane;
#pragma unroll
            for (int j = 0; j < 4; ++j) { const f32x4 y = v[j] * rinv * A[j] + Bv[j]; o8[64 * j] = (unsigned long long)pk2(y.x, y.y) | ((unsigned long long)pk2(y.z, y.w) << 32); }
        }
    }
}

struct Args { const float* in[13]; float* out; unsigned char* ws; int ph_lo, ph_hi; };
__global__ void __launch_bounds__(NWAVES * 64, 2) fwd_mega(Args args) {
    extern __shared__ __attribute__((aligned(16))) unsigned char lds[];
    LAS unsigned char* L = (LAS unsigned char*)lds;
    const int tid = threadIdx.x, lane = tid & 63, wave = __builtin_amdgcn_readfirstlane(tid >> 6);
    const int G = gridDim.x, bx = blockIdx.x, vcu = (G % 8 == 0) ? (bx % 8) * (G / 8) + bx / 8 : bx;
    const int gw = vcu * NWAVES + wave, NGW = G * NWAVES;
    unsigned char* ws = args.ws;
    const float *x = args.in[0], *cvec = args.in[1], *g_norm1 = args.in[2], *w_in = args.in[3], *g_q = args.in[4], *g_k = args.in[5], *rel_bias = args.in[6],
                *w_o = args.in[7], *g_norm2 = args.in[8], *w1 = args.in[9], *w2 = args.in[10], *w_ada = args.in[11], *b_ada = args.in[12];
    float* out = args.out; float* mod = (float*)(ws + WS_MOD);
    bf16* XN = (bf16*)(ws + WS_XN); bf16* PROJ = (bf16*)(ws + WS_PROJ); bf16* MIX = (bf16*)(ws + WS_MIX); bf16* HB = (bf16*)(ws + WS_H);
    const int lo = args.ph_lo, hi = args.ph_hi;
#define IN(k) (lo <= (k) && (k) < hi)
#define SEAM(k) do { if (IN(k) && IN((k) + 1)) { cg::this_grid().sync(); } } while (0)

    if (IN(0)) {
        LAS float* scr = (LAS float*)(L + wave * 16384);
        constexpr int I_IN = (D / 64) * (DIN / 32), I_O = (D / 64) * (D / 32), I_1 = (D / 64) * (FF / 32), I_2 = (FF / 64) * (D / 32), I_L = I_IN + I_O + I_1 + I_2;
        constexpr int I_MOD = DEPTH * (MODW / 64) * 16, NITEMS = I_MOD + DEPTH * I_L;
        for (int it = gw; it < NITEMS; it += NGW) {
            if (it < I_MOD) { mod_item(cvec, w_ada, b_ada, mod, it, lane); continue; }
            int r = it - I_MOD; const int l = r / I_L; r -= l * I_L; unsigned char* wb = ws + WS_W + (size_t)l * W_LAYER;
            if (r < I_IN) { transpose_item(w_in + (size_t)l * D * DIN, D, DIN, (bf16*)(wb + W_IN), scr, r, lane); continue; } r -= I_IN;
            if (r < I_O) { transpose_item(w_o + (size_t)l * D * D, D, D, (bf16*)(wb + W_O), scr, r, lane); continue; } r -= I_O;
            if (r < I_1) { transpose_item(w1 + (size_t)l * D * FF, D, FF, (bf16*)(wb + W_1), scr, r, lane); continue; } r -= I_1;
            transpose_item(w2 + (size_t)l * FF * D, FF, D, (bf16*)(wb + W_2), scr, r, lane);
        }
    }
    SEAM(0);
#pragma unroll
    for (int l = 0; l < DEPTH; ++l) {
        const int P = 1 + 7 * l;
        unsigned char* wb = ws + WS_W + (size_t)l * W_LAYER;
        const float* modl = mod + (size_t)l * BATCH * MODW;
        const float* xin = (l == 0) ? x : out;
        if (IN(P + 0)) { int ln = lane; asm volatile("" : "+v"(ln)); norm_phase(xin, XN, g_norm1 + l * D, modl, 0, D, gw, NGW, ln); }
        SEAM(P + 0);
        if (IN(P + 1)) {
            pg8::Gemm g{XN, (const bf16*)(wb + W_IN), M, DIN, D}; pg8::StaticOrder S; S.init(M, DIN, G, bx);
            pg8::EpiBf16<0> E{PROJ, DIN};
            pg8::gemm_phase<pg8::EpiBf16<0>, pg8::StaticOrder, true, true>(L, g, S, E);
        }
        SEAM(P + 1);
        if (IN(P + 2)) {
            LAS char* wl = (LAS char*)(L + wave * att::WAVE_LDS); int ln = lane; asm volatile("" : "+v"(ln));
            for (int u = gw; u < 8192; u += NGW) {
                const int kind = u >> 12, v = u & 4095, bh = v >> 7, qb = v & 127;
                if (kind == 0) att::sb_unit(PROJ, MIX, bh >> 3, bh & 7, qb, wl, ln);
                else att::ca_unit(PROJ, MIX, g_q + l * 64, g_k + l * 64, rel_bias + (size_t)l * 8 * NREL, bh >> 3, bh & 7, qb, wl, ln);
            }
        }
        SEAM(P + 2);
        if (IN(P + 3)) {
            pg8::Gemm g{MIX, (const bf16*)(wb + W_O), M, D, D}; pg8::StaticOrder S; S.init(M, D, G, bx);
            pg8::EpiResGate E{xin, out, modl + 2 * D, D, MODW, SEQ};
            pg8::gemm_phase<pg8::EpiResGate, pg8::StaticOrder, true, true>(L, g, S, E);
        }
        SEAM(P + 3);
        if (IN(P + 4)) { int ln = lane; asm volatile("" : "+v"(ln)); norm_phase(out, XN, g_norm2 + l * D, modl, 3 * D, 4 * D, gw, NGW, ln); }
        SEAM(P + 4);
        if (IN(P + 5)) {
            pg8::Gemm g{XN, (const bf16*)(wb + W_1), M, FF, D}; pg8::StaticOrder S; S.init(M, FF, G, bx);
            pg8::EpiBf16<2> E{HB, FF};
            pg8::gemm_phase<pg8::EpiBf16<2>, pg8::StaticOrder, true, true>(L, g, S, E);
        }
        SEAM(P + 5);
        if (IN(P + 6)) {
            pg8::Gemm g{HB, (const bf16*)(wb + W_2), M, D, FF}; pg8::StaticOrder S; S.init(M, D, G, bx);
            pg8::EpiResGate E{out, out, modl + 5 * D, D, MODW, SEQ};
            pg8::gemm_phase<pg8::EpiResGate, pg8::StaticOrder, true, true>(L, g, S, E);
        }
        SEAM(P + 6);
    }
#undef IN
#undef SEAM
}

extern "C" void kernel_launch(void* const* d_in, const int* in_sizes, int n_in, void* d_out, int out_size, void* d_ws, size_t ws_size, hipStream_t stream) {
    static int grid = 0;
    if (grid == 0) {
        if (n_in != 13 || out_size != M * D || ws_size < WS_END) { fprintf(stderr, "kernel_launch: unexpected shapes (n_in %d, out %d, ws %zu)\n", n_in, out_size, ws_size); grid = -1; return; }
        int dev = 0, cus = 0, per_cu = 0;
        hipGetDevice(&dev); hipDeviceGetAttribute(&cus, hipDeviceAttributeMultiprocessorCount, dev);
        if (hipFuncSetAttribute((const void*)fwd_mega, hipFuncAttributeMaxDynamicSharedMemorySize, LDS_BYTES) != hipSuccess) { fprintf(stderr, "kernel_launch: hipFuncSetAttribute failed\n"); grid = -1; return; }
        if (hipOccupancyMaxActiveBlocksPerMultiprocessor(&per_cu, (const void*)fwd_mega, NWAVES * 64, LDS_BYTES) != hipSuccess || per_cu < 1) { fprintf(stderr, "kernel_launch: occupancy query says %d\n", per_cu); per_cu = 1; }
        (void)hipGetLastError();
        grid = cus;
    }
    if (grid < 0) return;
    hipMemsetAsync((char*)d_ws + WS_CTL, 0, CTL_ZERO_BYTES, stream);
    Args a{};
    for (int i = 0; i < 13; ++i) a.in[i] = (const float*)d_in[i];
    a.out = (float*)d_out; a.ws = (unsigned char*)d_ws;
#if MK_MULTI
    for (int p = 0; p < NPHASE; ++p) { a.ph_lo = p; a.ph_hi = p + 1; hipLaunchKernelGGL(fwd_mega, dim3(grid), dim3(NWAVES * 64), LDS_BYTES, stream, a); }
#else
    a.ph_lo = 0; a.ph_hi = NPHASE;
    void* kargs[] = {&a};
    hipError_t e = hipLaunchCooperativeKernel((const void*)fwd_mega, dim3(grid), dim3(NWAVES * 64), kargs, LDS_BYTES, stream);
    if (e != hipSuccess) fprintf(stderr, "kernel_launch: cooperative launch failed: %s (grid %d)\n", hipGetErrorString(e), grid);
#endif
}
```

```cpp
#include <hip/hip_runtime.h>
#include <hip/hip_cooperative_groups.h>
#include <cstdio>
#include <cstdint>
namespace cg = cooperative_groups;
namespace pg8 {
#define PG8_LAS __attribute__((address_space(3)))
typedef unsigned short bf16_t;
typedef short bf16x8 __attribute__((ext_vector_type(8)));
typedef float f32x4 __attribute__((ext_vector_type(4)));
typedef unsigned u32x4 __attribute__((ext_vector_type(4)));
constexpr int BM = 256, BK = 64, HALF = 128, HTB = HALF * BK * 2  , STAGE_BYTES = 8 * HTB, NXCD = 8, WGM = 8;

__host__ __device__ __forceinline__ int lds_byte(int r, int c) { const int st = (r >> 4) * 2 + (c >> 5), rr = r & 15, cc = c & 31, ob = rr * 64 + cc * 2; return st * 1024 + (ob ^ (((ob >> 9) & 1) << 5)); }
__host__ __device__ __forceinline__ void stage_rc(int b, int& R, int& C) { const int st = b / 1024, sb = b % 1024, swz = sb ^ (((sb >> 9) & 1) << 5); R = (st >> 1) * 16 + swz / 64; C = (st & 1) * 32 + (swz % 64) / 2; }
__host__ __device__ __forceinline__ int perm32(int rho) { const int n = rho >> 4, i = rho & 15; return 8 * (i >> 2) + 4 * n + (i & 3); }

struct Unit { int pm, pn; };
struct Gemm { const bf16_t* A; const bf16_t* Bt; int M, N, K; };

struct StaticOrder {
    int nM, nN, nwg, G, c;
    __host__ __device__ void init(int M, int N, int G_, int c_) { nM = M / BM; nN = N / BM; nwg = nM * nN; G = G_; c = c_; }
    __host__ __device__ bool next(int i, Unit& u) const {
        const long L = (long)i * G + c; if (L >= nwg) return false;
        int wgid = (int)L; { const int q = nwg / NXCD, r = nwg % NXCD, xcd = wgid % NXCD, off = wgid / NXCD; wgid = (xcd < r ? xcd * (q + 1) : r * (q + 1) + (xcd - r) * q) + off; }
        const int nig = WGM * nN, gid = wgid / nig, fm = gid * WGM, gsz = (nM - fm) < WGM ? (nM - fm) : WGM;
        u.pm = fm + ((wgid % nig) % gsz); u.pn = (wgid % nig) / gsz; return true;
    }
    __device__ __forceinline__ void a_ready(const Unit&) const {}
    __device__ __forceinline__ void done(const Unit&) const {}
};

__device__ __forceinline__ unsigned cvt_pk_bf16(float lo, float hi) { unsigned r; asm volatile("v_cvt_pk_bf16_f32 %0, %1, %2" : "=v"(r) : "v"(lo), "v"(hi)); return r; }
typedef float f32x2 __attribute__((ext_vector_type(2)));
typedef unsigned u32x4 __attribute__((ext_vector_type(4)));
template <int ACT> struct EpiBf16 {
    static constexpr bool PERM = true, AFTER_DRAIN = false;
    bf16_t* O; int ldc;
    __device__ __forceinline__ void operator()(const f32x4 (&acc)[2][2][4][2], const Unit& u, int wr, int wc, int fr, int fq) const {
        const int row0 = u.pm * BM + wr * 64 + fr; const int col0 = u.pn * BM + wc * 32 + 8 * fq;
#pragma unroll
        for (int ai = 0; ai < 2; ++ai)
#pragma unroll
            for (int m = 0; m < 4; ++m) { bf16_t* rowp = O + (size_t)(row0 + ai * HALF + m * 16) * ldc + col0;
#pragma unroll
                for (int bj = 0; bj < 2; ++bj) { f32x4 v0 = acc[ai][bj][m][0], v1 = acc[ai][bj][m][1];
                    if (ACT == 2) {
#pragma unroll
                        for (int e = 0; e < 4; ++e) { const float a = fmaxf(v0[e], 0.f), b = fmaxf(v1[e], 0.f); v0[e] = a * a; v1[e] = b * b; } }
                    u32x4 w; w.x = cvt_pk_bf16(v0[0], v0[1]); w.y = cvt_pk_bf16(v0[2], v0[3]); w.z = cvt_pk_bf16(v1[0], v1[1]); w.w = cvt_pk_bf16(v1[2], v1[3]);
                    *(u32x4*)(rowp + bj * HALF) = w; } }
    }
};
struct EpiResGate {
    static constexpr bool PERM = false, AFTER_DRAIN = false;
    const float* base; float* out; const float* gate; int ldc, gate_ld, rows_per_batch;
    __device__ __forceinline__ void operator()(const f32x4 (&acc)[2][2][4][2], const Unit& u, int wr, int wc, int fr, int fq) const {
        const int col0 = u.pn * BM + wc * 32 + 4 * fq; const int b = (u.pm * BM) / rows_per_batch;
        f32x4 gv[2][2];
#pragma unroll
        for (int bj = 0; bj < 2; ++bj)
#pragma unroll
            for (int n = 0; n < 2; ++n) gv[bj][n] = *(const f32x4*)(gate + (size_t)b * gate_ld + col0 + bj * HALF + n * 16);
#pragma unroll
        for (int ai = 0; ai < 2; ++ai)
#pragma unroll
            for (int m = 0; m < 4; ++m) { const size_t off = (size_t)(u.pm * BM + ai * HALF + wr * 64 + m * 16 + fr) * ldc + col0;
#pragma unroll
                for (int bj = 0; bj < 2; ++bj)
#pragma unroll
                    for (int n = 0; n < 2; ++n) { const f32x4 bs = *(const f32x4*)(base + off + bj * HALF + n * 16);
                        *(f32x4*)(out + off + bj * HALF + n * 16) = bs + gv[bj][n] * acc[ai][bj][m][n]; } }
    }
};
template <class Epi, class Sched, bool ALIGN_EPI = false, bool SP2 = false>
__device__ __forceinline__ void gemm_phase(PG8_LAS unsigned char* lds, const Gemm g, const Sched& S, const Epi& E) {
    int tid0_ = threadIdx.x; asm volatile("" : "+v"(tid0_));
    const int tid = tid0_, wid = __builtin_amdgcn_readfirstlane(tid >> 6), lane = tid & 63, wr = wid >> 2, wc = wid & 3, fr = lane & 15, fq = lane >> 4;
    const int K = g.K, nt = K / BK;
    unsigned voffA[2], voffB[2];
#pragma unroll
    for (int i = 0; i < 2; ++i) { int R, C; stage_rc(tid * 16 + i * 8192, R, C); const int Rb = Epi::PERM ? ((R & ~31) + perm32(R & 31)) : R;
        voffA[i] = (unsigned)(R * K + C) * 2u; voffB[i] = (unsigned)(Rb * K + C) * 2u; }
    const size_t kstep = (size_t)(BK * 2);
    const size_t hstep = (size_t)HALF * K * 2;
    const size_t tstep = 2 * hstep;
    const unsigned ldsw = (unsigned)wid * 1024u;
    const int aoff = lds_byte(wr * 64 + fr, fq * 8), boff = lds_byte(wc * 32 + fr, fq * 8);
#define PG8_SA(b, h) (((b) * 2 + (h)) * HTB)
#define PG8_SB(b, h) ((4 + (b) * 2 + (h)) * HTB)
#define PG8_STAGE(bufoff, gbase, voff) do { _Pragma("unroll") for (int _i = 0; _i < 2; ++_i) \
        __builtin_amdgcn_global_load_lds((const unsigned*)((const char*)(gbase) + (voff)[_i]), (PG8_LAS unsigned*)(lds + (bufoff) + ldsw + _i * 8192), 16, 0, 0); } while (0)
#define PG8_LDA(dst, b, h) do { _Pragma("unroll") for (int m = 0; m < 4; ++m) _Pragma("unroll") for (int k = 0; k < 2; ++k) dst[m][k] = *(const PG8_LAS bf16x8*)(lds + PG8_SA(b, h) + aoff + m * 2048 + k * 1024); } while (0)
#define PG8_LDB(dst, b, h) do { _Pragma("unroll") for (int n = 0; n < 2; ++n) _Pragma("unroll") for (int k = 0; k < 2; ++k) dst[n][k] = *(const PG8_LAS bf16x8*)(lds + PG8_SB(b, h) + boff + n * 2048 + k * 1024); } while (0)
#define PG8_MMA(ai, bj, At, Bt) do { __builtin_amdgcn_s_setprio(1); _Pragma("unroll") for (int m = 0; m < 4; ++m) _Pragma("unroll") for (int n = 0; n < 2; ++n) _Pragma("unroll") for (int k = 0; k < 2; ++k) \
        acc[ai][bj][m][n] = __builtin_amdgcn_mfma_f32_16x16x32_bf16(Bt[n][k], At[m][k], acc[ai][bj][m][n], 0, 0, 0); __builtin_amdgcn_s_setprio(0); } while (0)
#define PG8_WAIT_V(n) asm volatile("s_waitcnt vmcnt(" #n ")" ::: "memory")
#define PG8_WAIT_L(n) asm volatile("s_waitcnt lgkmcnt(" #n ")" ::: "memory")
#define PG8_BAR __builtin_amdgcn_s_barrier()
#define PG8_SCHED __builtin_amdgcn_sched_barrier(0)
    Unit cur, nxt; int ui = 0;
    if (!S.next(0, cur)) return;
    f32x4 acc[2][2][4][2];
#pragma unroll
    for (int a = 0; a < 2; ++a)
#pragma unroll
        for (int b = 0; b < 2; ++b)
#pragma unroll
            for (int m = 0; m < 4; ++m)
#pragma unroll
                for (int n = 0; n < 2; ++n) acc[a][b][m][n] = (f32x4){0.f, 0.f, 0.f, 0.f};
    bf16x8 At[4][2], B0[2][2], B1[2][2];
    const char* cA = (const char*)g.A + (size_t)cur.pm * tstep; const char* cB = (const char*)g.Bt + (size_t)cur.pn * tstep;
    S.a_ready(cur);
    if constexpr (SP2) {
        PG8_STAGE(PG8_SB(0, 0), cB, voffB); PG8_STAGE(PG8_SB(0, 1), cB + hstep, voffB); PG8_STAGE(PG8_SA(0, 0), cA, voffA); PG8_STAGE(PG8_SA(0, 1), cA + hstep, voffA);
        if (wr == 1) PG8_BAR;
        PG8_WAIT_V(2); PG8_BAR;
        PG8_STAGE(PG8_SB(1, 0), cB + kstep, voffB); PG8_STAGE(PG8_SA(1, 0), cA + kstep, voffA); PG8_STAGE(PG8_SB(1, 1), cB + hstep + kstep, voffB);
        PG8_WAIT_V(6); PG8_BAR;
    } else {
        PG8_STAGE(PG8_SB(0, 0), cB, voffB); PG8_STAGE(PG8_SA(0, 0), cA, voffA); PG8_STAGE(PG8_SB(0, 1), cB + hstep, voffB); PG8_STAGE(PG8_SA(0, 1), cA + hstep, voffA);
        if (wr == 1) PG8_BAR;
        PG8_WAIT_V(4); PG8_BAR;
        PG8_STAGE(PG8_SB(1, 0), cB + kstep, voffB); PG8_STAGE(PG8_SA(1, 0), cA + kstep, voffA); PG8_STAGE(PG8_SB(1, 1), cB + hstep + kstep, voffB);
        PG8_WAIT_V(6); PG8_BAR;
    }
    for (;;) {
        const bool has_next = S.next(ui + 1, nxt);
        const char* nA = has_next ? (const char*)g.A + (size_t)nxt.pm * tstep : cA; const char* nB = has_next ? (const char*)g.Bt + (size_t)nxt.pn * tstep : cB;
        for (int t = 0; t < nt; t += 2) {
            const bool last = (t == nt - 2);
            const char* a1 = cA + (size_t)(t + 1) * kstep;
            const char* a2 = last ? nA : cA + (size_t)(t + 2) * kstep; const char* b2 = last ? nB : cB + (size_t)(t + 2) * kstep;
            const char* a3 = a2 + kstep; const char* b3 = b2 + kstep;
            if (last && has_next) S.a_ready(nxt);
            if constexpr (SP2) {
            PG8_LDB(B0, 0, 0); PG8_LDB(B1, 0, 1); PG8_SCHED; PG8_LDA(At, 0, 0); PG8_STAGE(PG8_SA(1, 1), a1 + hstep, voffA);
            PG8_WAIT_V(8); PG8_WAIT_L(0); PG8_BAR; PG8_MMA(0, 0, At, B0); PG8_MMA(0, 1, At, B1); PG8_BAR; PG8_SCHED;
            PG8_LDA(At, 0, 1); PG8_STAGE(PG8_SB(0, 0), b2, voffB); PG8_STAGE(PG8_SB(0, 1), b2 + hstep, voffB); PG8_STAGE(PG8_SA(0, 0), a2, voffA);
            PG8_WAIT_V(8); PG8_WAIT_L(0); PG8_BAR; PG8_MMA(1, 0, At, B0); PG8_MMA(1, 1, At, B1); PG8_BAR; PG8_SCHED;
            PG8_LDB(B0, 1, 0); PG8_LDB(B1, 1, 1); PG8_SCHED; PG8_LDA(At, 1, 0); PG8_STAGE(PG8_SA(0, 1), a2 + hstep, voffA);
            PG8_WAIT_V(8); PG8_WAIT_L(0); PG8_BAR; PG8_MMA(0, 0, At, B0); PG8_MMA(0, 1, At, B1); PG8_BAR; PG8_SCHED;
            PG8_LDA(At, 1, 1); PG8_STAGE(PG8_SB(1, 0), b3, voffB); PG8_STAGE(PG8_SB(1, 1), b3 + hstep, voffB); PG8_STAGE(PG8_SA(1, 0), a3, voffA);
            PG8_WAIT_V(8); PG8_WAIT_L(0); PG8_BAR; PG8_MMA(1, 0, At, B0); PG8_MMA(1, 1, At, B1); PG8_BAR; PG8_SCHED;
            } else {
            PG8_LDB(B0, 0, 0); PG8_SCHED; PG8_LDA(At, 0, 0); PG8_STAGE(PG8_SA(1, 1), a1 + hstep, voffA);
            PG8_WAIT_L(8); PG8_BAR; PG8_WAIT_L(0); PG8_MMA(0, 0, At, B0); PG8_BAR; PG8_SCHED;
            PG8_LDB(B1, 0, 1); PG8_STAGE(PG8_SB(0, 0), b2, voffB);
            PG8_BAR; PG8_WAIT_L(0); PG8_MMA(0, 1, At, B1); PG8_BAR;
            PG8_LDA(At, 0, 1); PG8_STAGE(PG8_SA(0, 0), a2, voffA);
            PG8_BAR; PG8_WAIT_L(0); PG8_MMA(1, 0, At, B0); PG8_BAR; PG8_SCHED;
            PG8_STAGE(PG8_SB(0, 1), b2 + hstep, voffB);
            PG8_WAIT_V(6); PG8_BAR; PG8_MMA(1, 1, At, B1); PG8_BAR;
            PG8_LDB(B0, 1, 0); PG8_SCHED; PG8_LDA(At, 1, 0); PG8_STAGE(PG8_SA(0, 1), a2 + hstep, voffA);
            PG8_WAIT_L(8); PG8_BAR; PG8_WAIT_L(0); PG8_MMA(0, 0, At, B0); PG8_BAR; PG8_SCHED;
            PG8_LDB(B1, 1, 1); PG8_STAGE(PG8_SB(1, 0), b3, voffB);
            PG8_BAR; PG8_WAIT_L(0); PG8_MMA(0, 1, At, B1); PG8_BAR;
            PG8_LDA(At, 1, 1); PG8_STAGE(PG8_SA(1, 0), a3, voffA);
            PG8_BAR; PG8_WAIT_L(0); PG8_MMA(1, 0, At, B0); PG8_BAR; PG8_SCHED;
            PG8_STAGE(PG8_SB(1, 1), b3 + hstep, voffB);
            PG8_WAIT_V(6); PG8_BAR; PG8_MMA(1, 1, At, B1); PG8_BAR;
            }
        }
        if constexpr (ALIGN_EPI) { if (wr == 0) PG8_BAR; }
        if constexpr (!Epi::AFTER_DRAIN) { E(acc, cur, wr, wc, fr, fq); S.done(cur); }
        if (!has_next) break;
#pragma unroll
        for (int a = 0; a < 2; ++a)
#pragma unroll
            for (int b = 0; b < 2; ++b)
#pragma unroll
                for (int m = 0; m < 4; ++m)
#pragma unroll
                    for (int n = 0; n < 2; ++n) acc[a][b][m][n] = (f32x4){0.f, 0.f, 0.f, 0.f};
        cur = nxt; cA = nA; cB = nB; ++ui;
        if constexpr (ALIGN_EPI) { if (wr == 1) PG8_BAR; }
    }
    PG8_WAIT_V(0);
    if constexpr (!ALIGN_EPI) { if (wr == 0) PG8_BAR; }
    PG8_BAR;
    if constexpr (Epi::AFTER_DRAIN) { E.fused(acc, cur, wr, wc, fr, fq, lds, wid, lane); S.done(cur); }
#undef PG8_SA
#undef PG8_SB
#undef PG8_STAGE
#undef PG8_LDA
#undef PG8_LDB
#undef PG8_MMA
#undef PG8_WAIT_V
#undef PG8_WAIT_L
#undef PG8_BAR
#undef PG8_SCHED
}
}
namespace att {
#define ATT_LAS __attribute__((address_space(3)))
typedef unsigned short bf16_t;
typedef short bf16x8 __attribute__((ext_vector_type(8)));
typedef _Float16 f16x8 __attribute__((ext_vector_type(8)));
typedef float f32x16 __attribute__((ext_vector_type(16)));
typedef float f32x4 __attribute__((ext_vector_type(4)));
typedef unsigned u32x4 __attribute__((ext_vector_type(4)));
typedef unsigned u32x2 __attribute__((ext_vector_type(2)));
typedef short v4i16_t __attribute__((ext_vector_type(4)));
constexpr int PP = 3072, SEQ = 4096, DM = 1024;
constexpr float LOG2E = 1.4426950408889634f, QS = 0.125f * 1.4426950408889634f, EPS = 1e-6f;
constexpr int WAVE_LDS = 8192;
__device__ __forceinline__ int crow(int r, int hi) { return (r & 3) + 8 * (r >> 2) + 4 * hi; }
typedef float f32x2_t __attribute__((ext_vector_type(2))); typedef __bf16 bf16x2_t __attribute__((ext_vector_type(2)));
__device__ __forceinline__ unsigned cvtpk(float lo, float hi) { f32x2_t v = {lo, hi}; bf16x2_t b = __builtin_convertvector(v, bf16x2_t); return __builtin_bit_cast(unsigned, b); }
__device__ __forceinline__ float bf2f(short s) { return __uint_as_float(((unsigned)(unsigned short)s) << 16); }
__device__ __forceinline__ float half_add(float v) { auto rr = __builtin_amdgcn_permlane32_swap(__float_as_uint(v), __float_as_uint(v), false, false); return __uint_as_float(rr[0]) + __uint_as_float(rr[1]); }
__device__ __forceinline__ float half_max(float v) { auto rr = __builtin_amdgcn_permlane32_swap(__float_as_uint(v), __float_as_uint(v), false, false); return fmaxf(__uint_as_float(rr[0]), __uint_as_float(rr[1])); }
__device__ __forceinline__ v4i16_t vtr(ATT_LAS const char* p) { return __builtin_amdgcn_ds_read_tr16_b64_v4i16((ATT_LAS v4i16_t*)p); }
#define ATT_FENCE() asm volatile("" ::: "memory")
#define ATT_LWAIT() asm volatile("s_waitcnt lgkmcnt(0)" ::: "memory")

__device__ __forceinline__ void pv_tile(f32x16& o0, f32x16& o1, ATT_LAS const char* wl, int lane, const bf16x8 (&pf)[2]) {
    const int hi = lane >> 5;
    ATT_LAS const char* vb = wl + (4 * hi + ((lane & 15) >> 2)) * 64 + ((lane >> 4) & 1) * 32 + (lane & 3) * 8;
#pragma unroll
    for (int db = 0; db < 2; ++db)
#pragma unroll
        for (int sl = 0; sl < 2; ++sl) {
            const v4i16_t lo = vtr(vb + (db * 2 + sl) * 1024), hh = vtr(vb + (db * 2 + sl) * 1024 + 512);
            const bf16x8 vf = (bf16x8){lo[0], lo[1], lo[2], lo[3], hh[0], hh[1], hh[2], hh[3]};
            if (db == 0) o0 = __builtin_amdgcn_mfma_f32_32x32x16_bf16(vf, pf[sl], o0, 0, 0, 0);
            else         o1 = __builtin_amdgcn_mfma_f32_32x32x16_bf16(vf, pf[sl], o1, 0, 0, 0);
        }
}
__device__ __forceinline__ void store_ot(bf16_t* Op, const f32x16& o0, const f32x16& o1, float sc) {
#pragma unroll
    for (int g = 0; g < 4; ++g) {
        u32x2 a, b; a.x = cvtpk(o0[4 * g] * sc, o0[4 * g + 1] * sc); a.y = cvtpk(o0[4 * g + 2] * sc, o0[4 * g + 3] * sc);
        b.x = cvtpk(o1[4 * g] * sc, o1[4 * g + 1] * sc); b.y = cvtpk(o1[4 * g + 2] * sc, o1[4 * g + 3] * sc);
        *(u32x2*)(Op + 8 * g) = a; *(u32x2*)(Op + 32 + 8 * g) = b;
    }
}

__device__ __forceinline__ void sb_unit(const bf16_t* proj, bf16_t* mix, int b, int h, int qb, ATT_LAS char* wl, int lane) {
    const int r32 = lane & 31, hi = lane >> 5, t0 = qb * 32;
    const size_t rowbase = (size_t)b * SEQ;
    const bf16_t* Qp = proj + (rowbase + t0 + r32) * PP + h * 64 + hi * 8;
    const bf16_t* Kp = proj + rowbase * PP + 512 + h * 64 + hi * 8;
    const bf16_t* Vp = proj + rowbase * PP + 1024 + h * 64 + 8 * (lane & 3);
    bf16x8 qr[4];
#pragma unroll
    for (int d0 = 0; d0 < 4; ++d0) qr[d0] = *(const bf16x8*)(Qp + d0 * 16);
    f16x8 uf[2];
#pragma unroll
    for (int sl = 0; sl < 2; ++sl)
#pragma unroll
        for (int j = 0; j < 8; ++j) uf[sl][j] = ((16 * sl + 8 * (j >> 2) + 4 * hi + (j & 3)) > r32) ? (_Float16)1.0f : (_Float16)0.0f;
    f32x16 o0 = {}, o1 = {}; float R = 0.f;
    bf16x8 kf[4]; u32x4 vv[4];
#pragma unroll
    for (int d0 = 0; d0 < 4; ++d0) kf[d0] = *(const bf16x8*)(Kp + (size_t)(t0 + r32) * PP + d0 * 16);
#pragma unroll
    for (int i = 0; i < 4; ++i) vv[i] = *(const u32x4*)(Vp + (size_t)(t0 + 16 * (i & 1) + (lane >> 2)) * PP + 32 * (i >> 1));
    for (int kt = qb; kt >= 0; --kt) {
        ATT_FENCE();
#pragma unroll
        for (int i = 0; i < 4; ++i) *(ATT_LAS u32x4*)(wl + i * 1024 + lane * 16) = vv[i];
        const int kn = (kt > 0 ? kt - 1 : 0) * 32;
        bf16x8 kfn[4];
#pragma unroll
        for (int d0 = 0; d0 < 4; ++d0) kfn[d0] = *(const bf16x8*)(Kp + (size_t)(kn + r32) * PP + d0 * 16);
#pragma unroll
        for (int i = 0; i < 4; ++i) vv[i] = *(const u32x4*)(Vp + (size_t)(kn + 16 * (i & 1) + (lane >> 2)) * PP + 32 * (i >> 1));
        f32x16 p = {};
#pragma unroll
        for (int d0 = 0; d0 < 4; ++d0) p = __builtin_amdgcn_mfma_f32_32x32x16_bf16(kf[d0], qr[d0], p, 0, 0, 0);
        const bool diag = (kt == qb);
        f32x16 lb; f16x8 lf[2];
#pragma unroll
        for (int r = 0; r < 16; ++r) {
            const float z = p[r] * QS, e = __builtin_amdgcn_exp2f(-fabsf(z)), lg = __builtin_amdgcn_logf(1.0f + e);
            const float lbv = fminf(z, 0.f) - lg; float l1 = lbv - z;
            if (diag && !(crow(r, hi) < r32)) l1 = 0.f;
            lb[r] = lbv; lf[r >> 3][r & 7] = (_Float16)l1;
        }
        f32x16 suf = {};
        suf = __builtin_amdgcn_mfma_f32_32x32x16_f16(uf[0], lf[0], suf, 0, 0, 0);
        suf = __builtin_amdgcn_mfma_f32_32x32x16_f16(uf[1], lf[1], suf, 0, 0, 0);
        const float tl = suf[0] + (float)lf[0][0];
        const float tot = __shfl(tl, r32);
        bf16x8 pf[2];
#pragma unroll
        for (int sl = 0; sl < 2; ++sl) {
            float w[8];
#pragma unroll
            for (int j = 0; j < 8; ++j) { const int r = 8 * sl + j; float wv = __builtin_amdgcn_exp2f(lb[r] + suf[r] + R); if (diag && !(crow(r, hi) < r32)) wv = 0.f; w[j] = wv; }
            u32x4 t; t.x = cvtpk(w[0], w[1]); t.y = cvtpk(w[2], w[3]); t.z = cvtpk(w[4], w[5]); t.w = cvtpk(w[6], w[7]);
            pf[sl] = __builtin_bit_cast(bf16x8, t);
        }
        R += tot;
        ATT_LWAIT();
        pv_tile(o0, o1, wl, lane, pf);
        ATT_FENCE();
        if (__all(R < -160.0f)) break;
#pragma unroll
        for (int d0 = 0; d0 < 4; ++d0) kf[d0] = kfn[d0];
    }
    store_ot(mix + (rowbase + t0 + r32) * DM + h * 64 + 4 * hi, o0, o1, 1.0f);
}

__device__ __forceinline__ void ca_unit(const bf16_t* proj, bf16_t* mix, const float* gq, const float* gk, const float* relb, int b, int h, int qb, ATT_LAS char* wl, int lane) {
    const int r32 = lane & 31, hi = lane >> 5, t0 = qb * 32, n = t0 >> 6, qi = (t0 & 63) + r32;
    const size_t rowbase = (size_t)b * SEQ;
    const bf16_t* Qp = proj + (rowbase + t0 + r32) * PP + 1536 + h * 64 + hi * 8;
    const bf16_t* Kp = proj + rowbase * PP + 2048 + h * 64 + hi * 8;
    const bf16_t* Vp = proj + rowbase * PP + 2560 + h * 64 + 8 * (lane & 3);
    ATT_LAS float* rks = (ATT_LAS float*)(wl + 4096);
    ATT_LAS float* bt = (ATT_LAS float*)(wl + 4352);
    for (int i = lane; i < 257; i += 64) bt[i] = relb[h * 257 + i] * LOG2E;
    bf16x8 qr[4];
    {
        bf16x8 qraw[4]; float ss = 0.f;
#pragma unroll
        for (int d0 = 0; d0 < 4; ++d0) { qraw[d0] = *(const bf16x8*)(Qp + d0 * 16);
#pragma unroll
            for (int j = 0; j < 8; ++j) { const float f = bf2f(qraw[d0][j]); ss += f * f; } }
        ss = half_add(ss);
        const float rinv = __builtin_amdgcn_rsqf(ss * (1.0f / 64.0f) + EPS) * QS;
#pragma unroll
        for (int d0 = 0; d0 < 4; ++d0) { float f[8];
#pragma unroll
            for (int j = 0; j < 8; ++j) { const int d = 16 * d0 + 8 * hi + j; f[j] = bf2f(qraw[d0][j]) * rinv * gq[d] * gk[d]; }
            u32x4 t; t.x = cvtpk(f[0], f[1]); t.y = cvtpk(f[2], f[3]); t.z = cvtpk(f[4], f[5]); t.w = cvtpk(f[6], f[7]);
            qr[d0] = __builtin_bit_cast(bf16x8, t); }
    }
    ATT_LWAIT();
    const float bconst = bt[256];
    f32x16 o0 = {}, o1 = {}; float mref = 0.f, l = 0.f;
    const int band0 = (n - 8) * 64;
    const int kstart = band0 < 0 ? 0 : band0;
    const int ntiles = (n * 64 + 64 - kstart) >> 5;
    bf16x8 kf[4]; u32x4 vv[4];
#pragma unroll
    for (int d0 = 0; d0 < 4; ++d0) kf[d0] = *(const bf16x8*)(Kp + (size_t)(kstart + r32) * PP + d0 * 16);
#pragma unroll
    for (int i = 0; i < 4; ++i) vv[i] = *(const u32x4*)(Vp + (size_t)(kstart + 16 * (i & 1) + (lane >> 2)) * PP + 32 * (i >> 1));
    for (int it = 0; it < ntiles; ++it) {
        const int k0 = kstart + 32 * it;
        ATT_FENCE();
#pragma unroll
        for (int i = 0; i < 4; ++i) *(ATT_LAS u32x4*)(wl + i * 1024 + lane * 16) = vv[i];
        const int kn = kstart + 32 * (it + 1 < ntiles ? it + 1 : it);
        bf16x8 kfn[4];
#pragma unroll
        for (int d0 = 0; d0 < 4; ++d0) kfn[d0] = *(const bf16x8*)(Kp + (size_t)(kn + r32) * PP + d0 * 16);
#pragma unroll
        for (int i = 0; i < 4; ++i) vv[i] = *(const u32x4*)(Vp + (size_t)(kn + 16 * (i & 1) + (lane >> 2)) * PP + 32 * (i >> 1));
        f32x16 p = {};
#pragma unroll
        for (int d0 = 0; d0 < 4; ++d0) p = __builtin_amdgcn_mfma_f32_32x32x16_bf16(kf[d0], qr[d0], p, 0, 0, 0);
        float ks = 0.f;
#pragma unroll
        for (int d0 = 0; d0 < 4; ++d0)
#pragma unroll
            for (int j = 0; j < 8; ++j) { const float f = bf2f(kf[d0][j]); ks += f * f; }
        ks = half_add(ks);
        const float rk = __builtin_amdgcn_rsqf(ks * (1.0f / 64.0f) + EPS);
        ATT_FENCE();
        rks[r32] = rk;
        ATT_LWAIT();
        float s[16];
#pragma unroll
        for (int g = 0; g < 4; ++g) { const f32x4 rv = *(ATT_LAS const f32x4*)(rks + 8 * g + 4 * hi);
#pragma unroll
            for (int e = 0; e < 4; ++e) s[4 * g + e] = p[4 * g + e] * rv[e]; }
        const int kj0 = k0 - band0;
        if (kj0 >= 384) {
#pragma unroll
            for (int r = 0; r < 16; ++r) { int rel = qi + 512 - (kj0 + crow(r, hi)); rel = rel < -128 ? -128 : (rel > 128 ? 128 : rel); s[r] += bt[rel + 128]; }
        } else {
#pragma unroll
            for (int r = 0; r < 16; ++r) s[r] += bconst;
        }
        float rm = s[0];
#pragma unroll
        for (int r = 1; r < 16; ++r) rm = fmaxf(rm, s[r]);
        rm = half_max(rm);
        if (it == 0) mref = rm;
        else if (__any(rm - mref > 14.0f)) {
            const float dl = fmaxf(rm - mref, 0.f), al = __builtin_amdgcn_exp2f(-dl);
#pragma unroll
            for (int r = 0; r < 16; ++r) { o0[r] *= al; o1[r] *= al; }
            l *= al; mref += dl;
        }
        float ls = 0.f; bf16x8 pf[2];
#pragma unroll
        for (int sl = 0; sl < 2; ++sl) {
            float w[8];
#pragma unroll
            for (int j = 0; j < 8; ++j) { w[j] = __builtin_amdgcn_exp2f(s[8 * sl + j] - mref); ls += w[j]; }
            u32x4 t; t.x = cvtpk(w[0], w[1]); t.y = cvtpk(w[2], w[3]); t.z = cvtpk(w[4], w[5]); t.w = cvtpk(w[6], w[7]);
            pf[sl] = __builtin_bit_cast(bf16x8, t);
        }
        l += ls;
        pv_tile(o0, o1, wl, lane, pf);
        ATT_FENCE();
#pragma unroll
        for (int d0 = 0; d0 < 4; ++d0) kf[d0] = kfn[d0];
    }
    l = half_add(l);
    store_ot(mix + (rowbase + t0 + r32) * DM + 512 + h * 64 + 4 * hi, o0, o1, 1.0f / l);
}
}
#ifndef MK_MULTI
#define MK_MULTI 0
#endif
constexpr int NWAVES = 8;
constexpr int BATCH = 4, SEQ = 4096, D = 1024, M = BATCH * SEQ, DIN = 3072, FF = 4096, DEPTH = 2, NREL = 257, MODW = 6 * D;
constexpr float RMS_EPS = 1e-6f;
constexpr size_t MiB = 1u << 20;
constexpr size_t WS_CTL = 0, CTL_ZERO_BYTES = 1 * MiB, WS_MOD = 65536;
constexpr size_t WS_W = 2 * MiB, W_LAYER = 24 * MiB, W_IN = 0, W_O = 6 * MiB, W_1 = 8 * MiB, W_2 = 16 * MiB;
constexpr size_t WS_XN = 64 * MiB, WS_PROJ = 96 * MiB, WS_MIX = 192 * MiB, WS_H = 96 * MiB, WS_END = 224 * MiB;
static_assert(WS_MOD + (size_t)DEPTH * BATCH * MODW * 4 <= CTL_ZERO_BYTES && WS_W + DEPTH * W_LAYER <= WS_XN && WS_H + (size_t)M * FF * 2 <= WS_END, "ws map");
constexpr int RING_BYTES = 131072, LDS_BYTES = 147456;
constexpr int NPHASE = 1 + 7 * DEPTH;

#define GAS __attribute__((address_space(1)))
#define LAS __attribute__((address_space(3)))
typedef unsigned short bf16;
typedef unsigned v4u __attribute__((ext_vector_type(4)));
typedef float f32x4 __attribute__((ext_vector_type(4)));
#define LDS_WAIT() asm volatile("s_waitcnt lgkmcnt(0)" ::: "memory")
__device__ __forceinline__ unsigned f2bf(float f) { unsigned u = __builtin_bit_cast(unsigned, f); return (u + 0x7fffu + ((u >> 16) & 1u)) >> 16; }
__device__ __forceinline__ unsigned pk2(float lo, float hi) { return f2bf(lo) | (f2bf(hi) << 16); }
__device__ __forceinline__ float wave_sum(float v) {
#pragma unroll
    for (int o = 1; o < 64; o <<= 1) v += __shfl_xor(v, o);
    return v;
}
__device__ __forceinline__ void transpose_item(const float* W, int K, int N, bf16* WT, LAS float* scr, int item, int lane) {
    const int nblk = N / 32, kb = item / nblk, nb = item % nblk, k0 = 64 * kb, n0 = 32 * nb;
#pragma unroll 8
    for (int i = 0; i < 32; ++i) { const int kk = 2 * i + (lane >> 5); scr[kk * 33 + (lane & 31)] = W[(size_t)(k0 + kk) * N + n0 + (lane & 31)]; }
    LDS_WAIT(); asm volatile("" ::: "memory");
    const int c = lane & 7;
#pragma unroll
    for (int j = 0; j < 4; ++j) { const int n = (lane >> 3) + 8 * j; const LAS float* s = scr + (8 * c) * 33 + n;
        v4u o; o.x = pk2(s[0 * 33], s[1 * 33]); o.y = pk2(s[2 * 33], s[3 * 33]); o.z = pk2(s[4 * 33], s[5 * 33]); o.w = pk2(s[6 * 33], s[7 * 33]);
        *(v4u*)(WT + (size_t)(n0 + n) * K + k0 + 8 * c) = o; }
    LDS_WAIT(); asm volatile("" ::: "memory");
}
__device__ __forceinline__ void mod_item(const float* cvec, const float* w_ada, const float* b_ada, float* mod, int item, int lane) {
    const int kc = item & 15, jb = (item >> 4) % (MODW / 64), l = (item >> 4) / (MODW / 64), j = jb * 64 + lane;
    float sv[BATCH];
#pragma unroll
    for (int b = 0; b < BATCH; ++b) { const float cv = cvec[b * D + kc * 64 + lane]; sv[b] = cv / (1.0f + __expf(-cv)); }
    float acc[BATCH] = {0.f, 0.f, 0.f, 0.f};
    const float* wp = w_ada + ((size_t)l * D + kc * 64) * MODW + j;
#pragma unroll 16
    for (int k = 0; k < 64; ++k) { const float w = wp[(size_t)k * MODW];
#pragma unroll
        for (int b = 0; b < BATCH; ++b) acc[b] += __uint_as_float(__builtin_amdgcn_readlane(__float_as_uint(sv[b]), k)) * w; }
    if (kc == 0) { const float bb = b_ada[l * MODW + j];
#pragma unroll
        for (int b = 0; b < BATCH; ++b) acc[b] += bb; }
#pragma unroll
    for (int b = 0; b < BATCH; ++b) atomicAdd(mod + ((size_t)l * BATCH + b) * MODW + j, acc[b]);
}
__device__ __forceinline__ void norm_phase(const float* X, bf16* XN, const float* g, const float* modl  , int sh_off, int sc_off, int gw, int NGW, int lane) {
    for (int m0 = gw * 8; m0 < M; m0 += NGW * 8) {
        const int b = m0 / SEQ; const float* mb = modl + (size_t)b * MODW;
        f32x4 A[4], Bv[4];
#pragma unroll
        for (int j = 0; j < 4; ++j) { const int c = 4 * lane + 256 * j; const f32x4 gv = *(const f32x4*)(g + c), sc = *(const f32x4*)(mb + sc_off + c); A[j] = gv * (sc + 1.0f); Bv[j] = *(const f32x4*)(mb + sh_off + c); }
        for (int i = 0; i < 8; ++i) {
            const f32x4* xr = (const f32x4*)(X + (size_t)(m0 + i) * D) + lane;
            f32x4 v[4]; float s = 0.f;
#pragma unroll
            for (int j = 0; j < 4; ++j) { v[j] = xr[64 * j]; s += (v[j].x * v[j].x + v[j].y * v[j].y) + (v[j].z * v[j].z + v[j].w * v[j].w); }
            const float rinv = 1.0f / sqrtf(wave_sum(s) * (1.0f / D) + RMS_EPS);
            unsigned long long* o8 = (unsigned long long*)(XN + (size_t)(m0 + i) * D) + lane;
#pragma unroll
            for (int j = 0; j < 4; ++j) { const f32x4 y = v[j] * rinv * A[j] + Bv[j]; o8[64 * j] = (unsigned long long)pk2(y.x, y.y) | ((unsigned long long)pk2(y.z, y.w) << 32); }
        }
    }
}

#define XB_TMO      128
#define XB_XCNT(j)  (256  + 64 * (j))
#define XB_XSUB(j)  (1280 + 64 * (j))
#define XB_XGEN(j)  (2304 + 64 * (j))
#define XB_TOP      3328
#define XB_TOPGEN   3392
#define XCD_BAR_WORDS 3456
#define XB_SPIN_CAP (1u << 18)

__device__ __forceinline__ unsigned xb_ld(unsigned* p)              { return __hip_atomic_load(p, __ATOMIC_RELAXED, __HIP_MEMORY_SCOPE_AGENT); }
__device__ __forceinline__ unsigned xb_add(unsigned* p, unsigned v) { return __hip_atomic_fetch_add(p, v, __ATOMIC_RELAXED, __HIP_MEMORY_SCOPE_AGENT); }
__device__ __forceinline__ unsigned xb_xcc_id() { return (unsigned)__builtin_amdgcn_s_getreg((3 << 11) | 20) & 0xFu; }
#define XB_SPIN(cond, bar) do { unsigned _sp = 0; while (cond) { __builtin_amdgcn_s_sleep(1); \
    if ((++_sp & 255u) == 0u) { if (xb_ld(&(bar)[XB_TMO])) break; if (_sp > XB_SPIN_CAP) { atomicAdd(&(bar)[XB_TMO], 1u); break; } } } } while (0)

struct XcdBarrier {
    unsigned* bar; unsigned x;
    volatile LAS unsigned* st;
};

__device__ __forceinline__ XcdBarrier xcd_barrier_post(unsigned* bar, volatile LAS unsigned* st) {
    XcdBarrier b; b.bar = bar; b.x = xb_xcc_id(); b.st = st;
    if (threadIdx.x == 0) (void)xb_add(&bar[XB_XCNT(b.x)], 1u);
    return b;
}
__device__ __forceinline__ void xcd_barrier_complete(unsigned* bar, unsigned x, unsigned& nloc, unsigned& nx) {
    const unsigned G = gridDim.x * gridDim.y * gridDim.z;
    unsigned sum, cnt, mine, sp = 0u;
    for (;;) {
        sum = 0u; cnt = 0u; mine = 0u;
#pragma unroll
        for (unsigned j = 0; j < 16; ++j) { const unsigned c = xb_ld(&bar[XB_XCNT(j)]); sum += c; cnt += (c > 0u) ? 1u : 0u; mine = (j == x) ? c : mine; }
        if (sum == G) break;
        __builtin_amdgcn_s_sleep(1);
        if ((++sp & 255u) == 0u) { if (xb_ld(&bar[XB_TMO])) break; if (sp > XB_SPIN_CAP) { atomicAdd(&bar[XB_TMO], 1u); break; } }
    }
    nloc = mine > 0u ? mine : 1u; nx = cnt > 0u ? cnt : 1u;
}

__device__ __forceinline__ void xcd_barrier(const XcdBarrier& b) {
    asm volatile("s_waitcnt vmcnt(0)" ::: "memory");
    __syncthreads();
    if (threadIdx.x == 0) {
        unsigned* bar = b.bar;
        __builtin_amdgcn_s_waitcnt(0);
        unsigned nloc = b.st[0], nx = b.st[1];
        if (nloc == 0u) { xcd_barrier_complete(bar, b.x, nloc, nx); b.st[0] = nloc; b.st[1] = nx; }
        const unsigned old = xb_add(&bar[XB_XSUB(b.x)], 1u);
        const unsigned gen = old / nloc;
        if (old + 1u == (gen + 1u) * nloc) {
            __builtin_amdgcn_fence(__ATOMIC_RELEASE, "agent");
            asm volatile("s_waitcnt vmcnt(0)" ::: "memory");
            const unsigned og = xb_add(&bar[XB_TOP], 1u);
            const unsigned tg = og / nx;
            if (og + 1u == (tg + 1u) * nx) xb_add(&bar[XB_TOPGEN], 1u);
            else XB_SPIN(xb_ld(&bar[XB_TOPGEN]) == tg, bar);
            __builtin_amdgcn_fence(__ATOMIC_ACQUIRE, "agent");
            xb_add(&bar[XB_XGEN(b.x)], 1u);
            asm volatile("s_waitcnt vmcnt(0)" ::: "memory");
        } else {
            XB_SPIN(xb_ld(&bar[XB_XGEN(b.x)]) == gen, bar);
            __builtin_amdgcn_fence(__ATOMIC_ACQUIRE, "agent");
            asm volatile("s_waitcnt vmcnt(0)" ::: "memory");
        }
    }
    __syncthreads();
}

struct Args { const float* in[13]; float* out; unsigned char* ws; int ph_lo, ph_hi; };
__global__ void __launch_bounds__(NWAVES * 64, 2) fwd_mega(Args args) {
    extern __shared__ __attribute__((aligned(16))) unsigned char lds[];
    LAS unsigned char* L = (LAS unsigned char*)lds;
    const int tid = threadIdx.x, lane = tid & 63, wave = __builtin_amdgcn_readfirstlane(tid >> 6);
    const int G = gridDim.x, bx = blockIdx.x, vcu = (G % 8 == 0) ? (bx % 8) * (G / 8) + bx / 8 : bx;
    const int gw = vcu * NWAVES + wave, NGW = G * NWAVES;
    unsigned char* ws = args.ws;
    const float *x = args.in[0], *cvec = args.in[1], *g_norm1 = args.in[2], *w_in = args.in[3], *g_q = args.in[4], *g_k = args.in[5], *rel_bias = args.in[6],
                *w_o = args.in[7], *g_norm2 = args.in[8], *w1 = args.in[9], *w2 = args.in[10], *w_ada = args.in[11], *b_ada = args.in[12];
    float* out = args.out; float* mod = (float*)(ws + WS_MOD);
    bf16* XN = (bf16*)(ws + WS_XN); bf16* PROJ = (bf16*)(ws + WS_PROJ); bf16* MIX = (bf16*)(ws + WS_MIX); bf16* HB = (bf16*)(ws + WS_H);
    const int lo = args.ph_lo, hi = args.ph_hi;
#define IN(k) (lo <= (k) && (k) < hi)
#define SEAM(k) do { if (IN(k) && IN((k) + 1)) { if ((k) == 0) cg::this_grid().sync(); else xcd_barrier(bar); } } while (0)
    volatile LAS unsigned* MISC = (volatile LAS unsigned*)(L + RING_BYTES);
    if (tid < 2) MISC[tid] = 0u;
    __syncthreads();
    XcdBarrier bar = xcd_barrier_post((unsigned*)(ws + WS_CTL) + 4096, MISC);

    if (IN(0)) {
        LAS float* scr = (LAS float*)(L + wave * 16384);
        constexpr int I_IN = (D / 64) * (DIN / 32), I_O = (D / 64) * (D / 32), I_1 = (D / 64) * (FF / 32), I_2 = (FF / 64) * (D / 32), I_L = I_IN + I_O + I_1 + I_2;
        constexpr int I_MOD = DEPTH * (MODW / 64) * 16, NITEMS = I_MOD + DEPTH * I_L;
        for (int it = gw; it < NITEMS; it += NGW) {
            if (it < I_MOD) { mod_item(cvec, w_ada, b_ada, mod, it, lane); continue; }
            int r = it - I_MOD; const int l = r / I_L; r -= l * I_L; unsigned char* wb = ws + WS_W + (size_t)l * W_LAYER;
            if (r < I_IN) { transpose_item(w_in + (size_t)l * D * DIN, D, DIN, (bf16*)(wb + W_IN), scr, r, lane); continue; } r -= I_IN;
            if (r < I_O) { transpose_item(w_o + (size_t)l * D * D, D, D, (bf16*)(wb + W_O), scr, r, lane); continue; } r -= I_O;
            if (r < I_1) { transpose_item(w1 + (size_t)l * D * FF, D, FF, (bf16*)(wb + W_1), scr, r, lane); continue; } r -= I_1;
            transpose_item(w2 + (size_t)l * FF * D, FF, D, (bf16*)(wb + W_2), scr, r, lane);
        }
    }
    SEAM(0);
#pragma unroll
    for (int l = 0; l < DEPTH; ++l) {
        const int P = 1 + 7 * l;
        unsigned char* wb = ws + WS_W + (size_t)l * W_LAYER;
        const float* modl = mod + (size_t)l * BATCH * MODW;
        const float* xin = (l == 0) ? x : out;
        if (IN(P + 0)) { int ln = lane; asm volatile("" : "+v"(ln)); norm_phase(xin, XN, g_norm1 + l * D, modl, 0, D, gw, NGW, ln); }
        SEAM(P + 0);
        if (IN(P + 1)) {
            pg8::Gemm g{XN, (const bf16*)(wb + W_IN), M, DIN, D}; pg8::StaticOrder S; S.init(M, DIN, G, bx);
            pg8::EpiBf16<0> E{PROJ, DIN};
            pg8::gemm_phase<pg8::EpiBf16<0>, pg8::StaticOrder, true, true>(L, g, S, E);
        }
        SEAM(P + 1);
        if (IN(P + 2)) {
            LAS char* wl = (LAS char*)(L + wave * att::WAVE_LDS); int ln = lane; asm volatile("" : "+v"(ln));
            for (int u = gw; u < 8192; u += NGW) {
                const int kind = u >> 12, v = u & 4095, bh = v >> 7, qb = v & 127;
                if (kind == 0) att::sb_unit(PROJ, MIX, bh >> 3, bh & 7, qb, wl, ln);
                else att::ca_unit(PROJ, MIX, g_q + l * 64, g_k + l * 64, rel_bias + (size_t)l * 8 * NREL, bh >> 3, bh & 7, qb, wl, ln);
            }
        }
        SEAM(P + 2);
        if (IN(P + 3)) {
            pg8::Gemm g{MIX, (const bf16*)(wb + W_O), M, D, D}; pg8::StaticOrder S; S.init(M, D, G, bx);
            pg8::EpiResGate E{xin, out, modl + 2 * D, D, MODW, SEQ};
            pg8::gemm_phase<pg8::EpiResGate, pg8::StaticOrder, true, true>(L, g, S, E);
        }
        SEAM(P + 3);
        if (IN(P + 4)) { int ln = lane; asm volatile("" : "+v"(ln)); norm_phase(out, XN, g_norm2 + l * D, modl, 3 * D, 4 * D, gw, NGW, ln); }
        SEAM(P + 4);
        if (IN(P + 5)) {
            pg8::Gemm g{XN, (const bf16*)(wb + W_1), M, FF, D}; pg8::StaticOrder S; S.init(M, FF, G, bx);
            pg8::EpiBf16<2> E{HB, FF};
            pg8::gemm_phase<pg8::EpiBf16<2>, pg8::StaticOrder, true, true>(L, g, S, E);
        }
        SEAM(P + 5);
        if (IN(P + 6)) {
            pg8::Gemm g{HB, (const bf16*)(wb + W_2), M, D, FF}; pg8::StaticOrder S; S.init(M, D, G, bx);
            pg8::EpiResGate E{out, out, modl + 5 * D, D, MODW, SEQ};
            pg8::gemm_phase<pg8::EpiResGate, pg8::StaticOrder, true, true>(L, g, S, E);
        }
        SEAM(P + 6);
    }
#undef IN
#undef SEAM
}

extern "C" void kernel_launch(void* const* d_in, const int* in_sizes, int n_in, void* d_out, int out_size, void* d_ws, size_t ws_size, hipStream_t stream) {
    static int grid = 0;
    if (grid == 0) {
        if (n_in != 13 || out_size != M * D || ws_size < WS_END) { fprintf(stderr, "kernel_launch: unexpected shapes (n_in %d, out %d, ws %zu)\n", n_in, out_size, ws_size); grid = -1; return; }
        int dev = 0, cus = 0, per_cu = 0;
        hipGetDevice(&dev); hipDeviceGetAttribute(&cus, hipDeviceAttributeMultiprocessorCount, dev);
        if (hipFuncSetAttribute((const void*)fwd_mega, hipFuncAttributeMaxDynamicSharedMemorySize, LDS_BYTES) != hipSuccess) { fprintf(stderr, "kernel_launch: hipFuncSetAttribute failed\n"); grid = -1; return; }
        if (hipOccupancyMaxActiveBlocksPerMultiprocessor(&per_cu, (const void*)fwd_mega, NWAVES * 64, LDS_BYTES) != hipSuccess || per_cu < 1) { fprintf(stderr, "kernel_launch: occupancy query says %d\n", per_cu); per_cu = 1; }
        (void)hipGetLastError();
        grid = cus;
    }
    if (grid < 0) return;
    hipMemsetAsync((char*)d_ws + WS_CTL, 0, CTL_ZERO_BYTES, stream);
    Args a{};
    for (int i = 0; i < 13; ++i) a.in[i] = (const float*)d_in[i];
    a.out = (float*)d_out; a.ws = (unsigned char*)d_ws;
#if MK_MULTI
    for (int p = 0; p < NPHASE; ++p) { a.ph_lo = p; a.ph_hi = p + 1; hipLaunchKernelGGL(fwd_mega, dim3(grid), dim3(NWAVES * 64), LDS_BYTES, stream, a); }
#else
    a.ph_lo = 0; a.ph_hi = NPHASE;
    void* kargs[] = {&a};
    hipError_t e = hipLaunchCooperativeKernel((const void*)fwd_mega, dim3(grid), dim3(NWAVES * 64), kargs, LDS_BYTES, stream);
    if (e != hipSuccess) fprintf(stderr, "kernel_launch: cooperative launch failed: %s (grid %d)\n", hipGetErrorString(e), grid);
#endif
}
```
